# Optimizing an MI355X kernel written in HIP

```python
import math
import jax, jax.numpy as jnp
from jax import lax
import numpy as np

D_MODEL = 1024
BATCH = 8
SEQ = 4096
DEPTH = 1

D_MIX = 2 * D_MODEL
ATTN_WIDTH = D_MIX // 2
SB_HEAD_DIM = 64
SB_HEADS = ATTN_WIDTH // SB_HEAD_DIM
SB_BLOCK = 128
SSD_WIDTH = D_MIX - ATTN_WIDTH
SSD_HEAD_DIM = 64
SSD_HEADS = SSD_WIDTH // SSD_HEAD_DIM
SSD_GROUPS = 2
SSD_STATE = 128
SSD_CONV_K = 4
SSD_CHUNK = 128
SSD_CONV_CH = SSD_WIDTH + 2 * SSD_GROUPS * SSD_STATE
IN_SPLITS = (ATTN_WIDTH, ATTN_WIDTH, ATTN_WIDTH, SSD_WIDTH, SSD_WIDTH,
             SSD_GROUPS * SSD_STATE, SSD_GROUPS * SSD_STATE, SSD_HEADS)
D_IN = sum(IN_SPLITS)
MEM_LEN = 256
XA_HEADS = 4
XA_HEAD_DIM = D_MODEL // XA_HEADS
D_FF = 2816
EPS = 1e-6

kernel_name = "hybrid_sb_ssd_macaron_layer"


def rmsnorm(x, g):
    x32 = x.astype(jnp.float32)
    y = x32 * lax.rsqrt(jnp.mean(x32 * x32, axis=-1, keepdims=True) + EPS)
    return (y * g.astype(jnp.float32)).astype(x.dtype)


def swiglu(h, w_gu, w_down):
    gu = h @ w_gu
    g, u = jnp.split(gu, 2, axis=-1)
    return (jax.nn.silu(g) * u) @ w_down


def stick_breaking_attention(q, k, v):
    b_, h_, s_, d_ = q.shape
    scale = 1.0 / math.sqrt(d_)
    outs = []
    for i in range(s_ // SB_BLOCK):
        t0, t1 = i * SB_BLOCK, (i + 1) * SB_BLOCK
        qb = q[:, :, t0:t1].astype(jnp.float32)
        kb = k[:, :, :t1].astype(jnp.float32)
        vb = v[:, :, :t1]
        z = jnp.einsum('bhtd,bhsd->bhts', qb, kb) * scale
        t_idx = t0 + jnp.arange(SB_BLOCK)
        s_idx = jnp.arange(t1)
        causal = s_idx[None, :] < t_idx[:, None]
        log_1mb = jnp.where(causal, jax.nn.log_sigmoid(-z), 0.0)
        suffix = lax.cumsum(log_1mb, axis=3, reverse=True) - log_1mb
        log_a = jnp.where(causal, jax.nn.log_sigmoid(z) + suffix, -jnp.inf)
        a = jnp.exp(log_a)
        outs.append(jnp.einsum('bhts,bhsd->bhtd', a, vb.astype(jnp.float32)))
    return jnp.concatenate(outs, axis=2).astype(v.dtype)


def ssd_chunked(xs, dt, a, bmat, cmat):
    b_, s_, h_, p_ = xs.shape
    L, G, N = SSD_CHUNK, SSD_GROUPS, SSD_STATE
    R = h_ // G
    nc = s_ // L
    x = (xs.astype(jnp.float32) * dt[..., None]).reshape(b_, nc, L, G, R, p_)
    adt = (dt * a).reshape(b_, nc, L, G, R).transpose(0, 3, 4, 1, 2)
    a_cs = jnp.cumsum(adt, axis=-1)
    bc = bmat.astype(jnp.float32).reshape(b_, nc, L, G, N)
    cc = cmat.astype(jnp.float32).reshape(b_, nc, L, G, N)
    tri = jnp.tril(jnp.ones((L, L), dtype=bool))
    diff = a_cs[..., :, None] - a_cs[..., None, :]
    lmat = jnp.exp(jnp.where(tri, diff, -jnp.inf))
    cb = jnp.einsum('bclgn,bcsgn->bcgls', cc, bc)
    y_diag = jnp.einsum('bcgls,bgrcls,bcsgrp->bclgrp', cb, lmat, x)
    decay_states = jnp.exp(a_cs[..., -1:] - a_cs)
    states = jnp.einsum('bclgn,bgrcl,bclgrp->bcgrpn', bc, decay_states, x)
    chunk_decay = jnp.exp(a_cs[..., -1])

    def step(h, inp):
        st, dec = inp
        return h * dec[..., None, None] + st, h

    h0 = jnp.zeros_like(states[:, 0])
    _, states_in = lax.scan(step, h0, (jnp.moveaxis(states, 1, 0),
                                       jnp.moveaxis(chunk_decay, -1, 0)))
    states_in = jnp.moveaxis(states_in, 0, 1)
    y_off = jnp.einsum('bclgn,bcgrpn,bgrcl->bclgrp', cc, states_in, jnp.exp(a_cs))
    return (y_diag + y_off).reshape(b_, s_, h_, p_)


def hybrid_mixer(u, w_in, conv_w, conv_b, dt_bias, a_log, d_skip,
                 ssd_norm_g, attn_norm_g, w_out):
    b_, s_, _ = u.shape
    proj = u @ w_in
    q, k, v, z, xs, bm, cm, dt_raw = jnp.split(proj, np.cumsum(IN_SPLITS)[:-1], axis=-1)
    def heads(t):
        return t.reshape(b_, s_, SB_HEADS, SB_HEAD_DIM).transpose(0, 2, 1, 3)
    o_att = stick_breaking_attention(heads(q), heads(k), heads(v))
    o_att = o_att.transpose(0, 2, 1, 3).reshape(b_, s_, ATTN_WIDTH)
    o_att = rmsnorm(o_att, attn_norm_g)
    xbc = jnp.concatenate([xs, bm, cm], axis=-1)
    xbc = lax.conv_general_dilated(
        xbc, conv_w.astype(xbc.dtype)[:, None, :], window_strides=(1,),
        padding=[(SSD_CONV_K - 1, 0)], dimension_numbers=('NWC', 'WIO', 'NWC'),
        feature_group_count=SSD_CONV_CH)
    xbc = jax.nn.silu(xbc + conv_b)
    xs, bm, cm = jnp.split(xbc, [SSD_WIDTH, SSD_WIDTH + SSD_GROUPS * SSD_STATE], axis=-1)
    xs = xs.reshape(b_, s_, SSD_HEADS, SSD_HEAD_DIM)
    bm = bm.reshape(b_, s_, SSD_GROUPS, SSD_STATE)
    cm = cm.reshape(b_, s_, SSD_GROUPS, SSD_STATE)
    dt = jax.nn.softplus(dt_raw.astype(jnp.float32) + dt_bias.astype(jnp.float32))
    a = -jnp.exp(a_log.astype(jnp.float32))
    y = ssd_chunked(xs, dt, a, bm, cm)
    y = y + d_skip.astype(jnp.float32)[:, None] * xs.astype(jnp.float32)
    y = y.reshape(b_, s_, SSD_WIDTH) * jax.nn.silu(z.astype(jnp.float32))
    y = rmsnorm(y.reshape(b_, s_, SSD_GROUPS, SSD_WIDTH // SSD_GROUPS),
                ssd_norm_g.reshape(SSD_GROUPS, SSD_WIDTH // SSD_GROUPS))
    o_ssd = y.reshape(b_, s_, SSD_WIDTH).astype(u.dtype)
    return jnp.concatenate([o_att, o_ssd], axis=-1) @ w_out


def memory_cross_attention(h, mem_n, wq, wkv, wo):
    b_, s_, _ = h.shape
    q = (h @ wq).reshape(b_, s_, XA_HEADS, XA_HEAD_DIM)
    kv = mem_n @ wkv
    k, v = jnp.split(kv, 2, axis=-1)
    k = k.reshape(b_, MEM_LEN, XA_HEADS, XA_HEAD_DIM)
    v = v.reshape(b_, MEM_LEN, XA_HEADS, XA_HEAD_DIM)
    sc = jnp.einsum('bshd,bmhd->bhsm', q.astype(jnp.float32), k.astype(jnp.float32))
    p = jax.nn.softmax(sc / math.sqrt(XA_HEAD_DIM), axis=-1)
    o = jnp.einsum('bhsm,bmhd->bshd', p, v.astype(jnp.float32)).astype(h.dtype)
    return o.reshape(b_, s_, D_MODEL) @ wo


def setup_inputs(seed: int = 0) -> dict:
    key = jax.random.key(seed)
    ks = iter(jax.random.split(key, 40))

    def w(shape, fan_in):
        return jax.random.normal(next(ks), (DEPTH,) + shape, jnp.float32) * fan_in ** -0.5

    def gain(n):
        return 1.0 + 0.02 * jax.random.normal(next(ks), (DEPTH, n), jnp.float32)

    x = jax.random.normal(next(ks), (BATCH, SEQ, D_MODEL), jnp.float32)
    mem = jax.random.normal(next(ks), (BATCH, MEM_LEN, D_MODEL), jnp.float32)
    dt0 = jnp.exp(jax.random.uniform(next(ks), (DEPTH, SSD_HEADS), jnp.float32,
                                     math.log(1e-3), math.log(1e-1)))
    dt_bias = dt0 + jnp.log(-jnp.expm1(-dt0))
    a_log = jnp.log(jax.random.uniform(next(ks), (DEPTH, SSD_HEADS), jnp.float32, 1.0, 16.0))
    return {
        "x": x, "mem": mem,
        "ffn1_pre_g": gain(D_MODEL),
        "ffn1_w_gu": w((D_MODEL, 2 * D_FF), D_MODEL),
        "ffn1_w_down": w((D_FF, D_MODEL), D_FF),
        "ffn1_post_g": gain(D_MODEL),
        "mix_pre_g": gain(D_MODEL),
        "w_in": w((D_MODEL, D_IN), D_MODEL),
        "conv_w": w((SSD_CONV_K, SSD_CONV_CH), SSD_CONV_K),
        "conv_b": 0.02 * jax.random.normal(next(ks), (DEPTH, SSD_CONV_CH), jnp.float32),
        "dt_bias": dt_bias,
        "a_log": a_log,
        "d_skip": 1.0 + 0.1 * jax.random.normal(next(ks), (DEPTH, SSD_HEADS), jnp.float32),
        "ssd_norm_g": gain(SSD_WIDTH),
        "attn_norm_g": gain(ATTN_WIDTH),
        "w_out": w((D_MIX, D_MODEL), D_MIX),
        "mix_post_g": gain(D_MODEL),
        "xa_pre_g": gain(D_MODEL),
        "mem_g": gain(D_MODEL),
        "xa_wq": w((D_MODEL, D_MODEL), D_MODEL),
        "xa_wkv": w((D_MODEL, 2 * D_MODEL), D_MODEL),
        "xa_wo": w((D_MODEL, D_MODEL), D_MODEL),
        "xa_post_g": gain(D_MODEL),
        "ffn2_pre_g": gain(D_MODEL),
        "ffn2_w_gu": w((D_MODEL, 2 * D_FF), D_MODEL),
        "ffn2_w_down": w((D_FF, D_MODEL), D_FF),
        "ffn2_post_g": gain(D_MODEL),
    }


def reference(x, mem, ffn1_pre_g, ffn1_w_gu, ffn1_w_down, ffn1_post_g,
              mix_pre_g, w_in, conv_w, conv_b, dt_bias, a_log, d_skip,
              ssd_norm_g, attn_norm_g, w_out, mix_post_g,
              xa_pre_g, mem_g, xa_wq, xa_wkv, xa_wo, xa_post_g,
              ffn2_pre_g, ffn2_w_gu, ffn2_w_down, ffn2_post_g):
    h = x
    for l in range(DEPTH):
        f = swiglu(rmsnorm(h, ffn1_pre_g[l]), ffn1_w_gu[l], ffn1_w_down[l])
        h = h + 0.5 * rmsnorm(f, ffn1_post_g[l])
        m = hybrid_mixer(rmsnorm(h, mix_pre_g[l]), w_in[l], conv_w[l], conv_b[l],
                         dt_bias[l], a_log[l], d_skip[l], ssd_norm_g[l],
                         attn_norm_g[l], w_out[l])
        h = h + rmsnorm(m, mix_post_g[l])
        c = memory_cross_attention(rmsnorm(h, xa_pre_g[l]), rmsnorm(mem, mem_g[l]),
                                   xa_wq[l], xa_wkv[l], xa_wo[l])
        h = h + rmsnorm(c, xa_post_g[l])
        f = swiglu(rmsnorm(h, ffn2_pre_g[l]), ffn2_w_gu[l], ffn2_w_down[l])
        h = h + 0.5 * rmsnorm(f, ffn2_post_g[l])
    return h
```

```cpp
#include <hip/hip_runtime.h>
#include <hip/hip_cooperative_groups.h>
#include <cstdio>
#include <cstdint>
namespace cg = cooperative_groups;

#define LAS __attribute__((address_space(3)))
typedef unsigned short bf16_t;
typedef short bf16x8 __attribute__((ext_vector_type(8)));
typedef short bf16x4 __attribute__((ext_vector_type(4)));
typedef float f32x4 __attribute__((ext_vector_type(4)));
typedef float f32x16 __attribute__((ext_vector_type(16)));
typedef unsigned u32x4 __attribute__((ext_vector_type(4)));
typedef unsigned u32x2 __attribute__((ext_vector_type(2)));

constexpr int MTOK = 32768, DM = 1024, SEQ = 4096, NB = 8;
constexpr int DFF = 2816, NGU = 5632;
constexpr int LDP = 5632;
constexpr int NIN = 5888;
constexpr int DIN_SRC = 5648;
constexpr int PQ = 0, PZ = 1024, PK = 2048, PV = 3072, PX = 4096;
constexpr float EPS = 1e-6f;
constexpr int NWAVES = 8;

constexpr size_t MiB = 1u << 20;
constexpr size_t WS_CTL = 0;
constexpr size_t WS_WGU1 = 2 * MiB, WS_WD1 = 13 * MiB, WS_WIN = 19 * MiB, WS_WOUT = 31 * MiB, WS_WQ = 35 * MiB, WS_WKV = 37 * MiB, WS_WO = 41 * MiB;
constexpr size_t WS_WGU2 = 43 * MiB, WS_WD2 = 54 * MiB, WS_MEMN = 60 * MiB, WS_K2 = 64 * MiB, WS_VT = 68 * MiB, WS_DT = 72 * MiB;
constexpr size_t WS_XN = 76 * MiB;
constexpr size_t WS_BIG = 140 * MiB;
constexpr size_t WS_WQK = 492 * MiB;
constexpr size_t WS_END = 508 * MiB;

typedef float f32x2_t __attribute__((ext_vector_type(2))); typedef __bf16 bf16x2_t __attribute__((ext_vector_type(2)));
__device__ __forceinline__ unsigned pk2(float lo, float hi) { const f32x2_t v = {lo, hi}; const bf16x2_t b = __builtin_convertvector(v, bf16x2_t); return __builtin_bit_cast(unsigned, b); }
__device__ __forceinline__ unsigned f2bf(float f) { return pk2(f, f) & 0xffffu; }
__device__ __forceinline__ float bf2f(unsigned short b) { return __builtin_bit_cast(float, (unsigned)b << 16); }
__device__ __forceinline__ float bflo(unsigned w) { return __builtin_bit_cast(float, w << 16); }
__device__ __forceinline__ float bfhi(unsigned w) { return __builtin_bit_cast(float, w & 0xffff0000u); }
__device__ __forceinline__ float wave_sum(float v) {
#pragma unroll
    for (int o = 1; o < 64; o <<= 1) v += __shfl_xor(v, o);
    return v;
}
__device__ __forceinline__ float silu_f(float v) { return v * __builtin_amdgcn_rcpf(1.f + __expf(-v)); }
__device__ __forceinline__ float softplus_f(float z) { return fmaxf(z, 0.f) + __logf(1.f + __expf(-fabsf(z))); }
__device__ __forceinline__ int crow(int r, int hi) { return (r & 3) + 8 * (r >> 2) + 4 * hi; }

namespace pg8 {
constexpr int BM = 256, BK = 64, HALF = 128, HTB = HALF * BK * 2, STAGE_BYTES = 8 * HTB, NXCD = 8, WGM = 8;
__device__ __forceinline__ int lds_byte(int r, int c) { const int st = (r >> 4) * 2 + (c >> 5), rr = r & 15, cc = c & 31, ob = rr * 64 + cc * 2; return st * 1024 + (ob ^ (((ob >> 9) & 1) << 5)); }
__device__ __forceinline__ void stage_rc(int b, int& R, int& C) { const int st = b / 1024, sb = b % 1024, swz = sb ^ (((sb >> 9) & 1) << 5); R = (st >> 1) * 16 + swz / 64; C = (st & 1) * 32 + (swz % 64) / 2; }
__device__ __forceinline__ int perm32(int rho) { const int n = rho >> 4, i = rho & 15; return 8 * (i >> 2) + 4 * n + (i & 3); }

struct Unit { int pm, pn, bt; const char* a; const char* b; long o; int r; };
struct Sched {
    const char* A; const char* B; int lda, ldb, K;
    int nM, nN, nBt, nH; long sAb, sAh, sBb, sBh, sOb, sOh; int sRb; int G, c;
    __device__ __forceinline__ bool next(int i, Unit& u) const {
        if (c < 0) return false;
        const int per = nM * nN; const long nwgl = (long)per * nBt; const long L = (long)i * G + c; if (L >= nwgl) return false;
        int bt = (int)(L / per); int wgid = (int)(L % per);
        if (nBt == 1) {
            const int nwg = per; const int q = nwg / NXCD, r = nwg % NXCD, xcd = wgid % NXCD, off = wgid / NXCD; wgid = (xcd < r ? xcd * (q + 1) : r * (q + 1) + (xcd - r) * q) + off;
            const int nig = WGM * nN, gid = wgid / nig, fm = gid * WGM, gsz = (nM - fm) < WGM ? (nM - fm) : WGM;
            u.pm = fm + ((wgid % nig) % gsz); u.pn = (wgid % nig) / gsz;
        } else if (nBt == 8 && nM == 16 && nN == 4 && G == 256) {
            const int slot = i * 8 + (c & 7), j = c >> 3; bt = slot >> 1; u.pm = (slot & 1) * 8 + (j & 7); u.pn = j >> 3;
        } else { u.pm = wgid % nM; u.pn = wgid / nM; }
        u.bt = bt; const int bb = bt / nH, hh = bt % nH;
        u.a = A + bb * sAb + hh * sAh + (size_t)u.pm * BM * lda * 2;
        u.b = B + bb * sBb + hh * sBh + (size_t)u.pn * BM * ldb * 2;
        u.o = bb * sOb + hh * sOh; u.r = bb * sRb;
        return true;
    }
};
__device__ __forceinline__ Sched make_sched(const void* A, int lda, const void* B, int ldb, int M, int N, int K, int G, int c) {
    Sched s; s.A = (const char*)A; s.B = (const char*)B; s.lda = lda; s.ldb = ldb; s.K = K; s.nM = M / BM; s.nN = N / BM; s.nBt = 1; s.nH = 1;
    s.sAb = s.sAh = s.sBb = s.sBh = s.sOb = s.sOh = 0; s.sRb = 0; s.G = G; s.c = c; return s;
}

__device__ __forceinline__ unsigned cvt_pk_bf16(float lo, float hi) { unsigned r; asm volatile("v_cvt_pk_bf16_f32 %0, %1, %2" : "=v"(r) : "v"(lo), "v"(hi)); return r; }

__device__ __forceinline__ float row_scale(const float* rs, int row, bool part) {
    if (!part) return rs[row];
    const f32x4 p = *(const f32x4*)(rs + (size_t)row * 4); return rsqrtf(((p.x + p.y) + (p.z + p.w)) * (1.f / 1024.f) + 1e-6f);
}
struct EpiStore {
    bf16_t* O; int ldc;
    __device__ __forceinline__ void operator()(const f32x4 (&acc)[2][2][4][2], const Unit& u, int wr, int wc, int fr, int fq) const {
        const int row0 = u.pm * BM + wr * 64 + fr; const int col0 = u.pn * BM + wc * 32 + 8 * fq; bf16_t* base = O + u.o;
#pragma unroll
        for (int ai = 0; ai < 2; ++ai)
#pragma unroll
            for (int m = 0; m < 4; ++m) { bf16_t* rowp = base + (size_t)(row0 + ai * HALF + m * 16) * ldc + col0;
#pragma unroll
                for (int bj = 0; bj < 2; ++bj) { const f32x4 v0 = acc[ai][bj][m][0], v1 = acc[ai][bj][m][1];
                    u32x4 w; w.x = cvt_pk_bf16(v0[0], v0[1]); w.y = cvt_pk_bf16(v0[2], v0[3]); w.z = cvt_pk_bf16(v1[0], v1[1]); w.w = cvt_pk_bf16(v1[2], v1[3]);
                    *(u32x4*)(rowp + bj * HALF) = w; } }
    }
};
struct EpiSwiglu {
    bf16_t* O; int ldc; const float* rs; bool part;
    __device__ __forceinline__ void operator()(const f32x4 (&acc)[2][2][4][2], const Unit& u, int wr, int wc, int fr, int fq) const {
        const int row0 = u.pm * BM + wr * 64 + fr; const int col0 = u.pn * HALF + wc * 32 + 8 * fq;
#pragma unroll
        for (int ai = 0; ai < 2; ++ai)
#pragma unroll
            for (int m = 0; m < 4; ++m) { bf16_t* rowp = O + (size_t)(row0 + ai * HALF + m * 16) * ldc + col0; const float sc = row_scale(rs, row0 + ai * HALF + m * 16, part);
                float r[8];
#pragma unroll
                for (int n = 0; n < 2; ++n)
#pragma unroll
                    for (int j = 0; j < 4; ++j) { const float g = acc[ai][0][m][n][j] * sc, uu = acc[ai][1][m][n][j] * sc; r[4 * n + j] = g * __builtin_amdgcn_rcpf(1.f + __expf(-g)) * uu; }
                u32x4 w; w.x = cvt_pk_bf16(r[0], r[1]); w.y = cvt_pk_bf16(r[2], r[3]); w.z = cvt_pk_bf16(r[4], r[5]); w.w = cvt_pk_bf16(r[6], r[7]);
                *(u32x4*)rowp = w; }
    }
};
struct EpiInProj {
    bf16_t* O; float* DT; const float* rs; bool part;
    __device__ __forceinline__ void operator()(const f32x4 (&acc)[2][2][4][2], const Unit& u, int wr, int wc, int fr, int fq) const {
        const int row0 = u.pm * BM + wr * 64 + fr;
        if (u.pn < 22) {
            const int col0 = u.pn * BM + wc * 32 + 8 * fq;
#pragma unroll
            for (int ai = 0; ai < 2; ++ai)
#pragma unroll
                for (int m = 0; m < 4; ++m) { bf16_t* rowp = O + (size_t)(row0 + ai * HALF + m * 16) * LDP + col0; const float sc = row_scale(rs, row0 + ai * HALF + m * 16, part);
#pragma unroll
                    for (int bj = 0; bj < 2; ++bj) { const f32x4 v0 = acc[ai][bj][m][0] * sc, v1 = acc[ai][bj][m][1] * sc;
                        u32x4 w; w.x = cvt_pk_bf16(v0[0], v0[1]); w.y = cvt_pk_bf16(v0[2], v0[3]); w.z = cvt_pk_bf16(v1[0], v1[1]); w.w = cvt_pk_bf16(v1[2], v1[3]);
                        *(u32x4*)(rowp + bj * HALF) = w; } }
        } else if (wc == 0 && fq < 2) {
#pragma unroll
            for (int ai = 0; ai < 2; ++ai)
#pragma unroll
                for (int m = 0; m < 4; ++m) { float* rowp = DT + (size_t)(row0 + ai * HALF + m * 16) * 16 + 8 * fq; const float sc = row_scale(rs, row0 + ai * HALF + m * 16, part);
                    *(f32x4*)rowp = acc[ai][0][m][0] * sc; *(f32x4*)(rowp + 4) = acc[ai][0][m][1] * sc; }
        }
    }
};
struct EpiSoftmax {
    bf16_t* O; int ldc; float scale; LAS float* X; const float* rs;
    __device__ __forceinline__ void operator()(f32x4 (&acc)[2][2][4][2], const Unit& u, int wr, int wc, int fr, int fq) const {
        float mx[2][4];
#pragma unroll
        for (int ai = 0; ai < 2; ++ai)
#pragma unroll
            for (int m = 0; m < 4; ++m) { float a = -3.0e38f;
#pragma unroll
                for (int bj = 0; bj < 2; ++bj)
#pragma unroll
                    for (int n = 0; n < 2; ++n)
#pragma unroll
                        for (int j = 0; j < 4; ++j) a = fmaxf(a, acc[ai][bj][m][n][j]);
                a = fmaxf(a, __shfl_xor(a, 16)); a = fmaxf(a, __shfl_xor(a, 32));
                if (fq == 0) X[(ai * HALF + wr * 64 + m * 16 + fr) * 4 + wc] = a; }
        asm volatile("s_waitcnt lgkmcnt(0)" ::: "memory"); __builtin_amdgcn_s_barrier(); asm volatile("" ::: "memory");
#pragma unroll
        for (int ai = 0; ai < 2; ++ai)
#pragma unroll
            for (int m = 0; m < 4; ++m) { const f32x4 t = *(const LAS f32x4*)(X + (ai * HALF + wr * 64 + m * 16 + fr) * 4);
                const float rm = fmaxf(fmaxf(t[0], t[1]), fmaxf(t[2], t[3])); float s = 0.f; const float scl = scale * row_scale(rs, u.r + u.pm * BM + ai * HALF + wr * 64 + m * 16 + fr, true);
#pragma unroll
                for (int bj = 0; bj < 2; ++bj)
#pragma unroll
                    for (int n = 0; n < 2; ++n)
#pragma unroll
                        for (int j = 0; j < 4; ++j) { const float e = __expf((acc[ai][bj][m][n][j] - rm) * scl); acc[ai][bj][m][n][j] = e; s += e; }
                s += __shfl_xor(s, 16); s += __shfl_xor(s, 32);
                if (fq == 0) X[1024 + (ai * HALF + wr * 64 + m * 16 + fr) * 4 + wc] = s; mx[ai][m] = 0.f; }
        asm volatile("s_waitcnt lgkmcnt(0)" ::: "memory"); __builtin_amdgcn_s_barrier(); asm volatile("" ::: "memory");
        const int row0 = u.pm * BM + wr * 64 + fr; const int col0 = u.pn * BM + wc * 32 + 8 * fq; bf16_t* base = O + u.o;
#pragma unroll
        for (int ai = 0; ai < 2; ++ai)
#pragma unroll
            for (int m = 0; m < 4; ++m) { const f32x4 t = *(const LAS f32x4*)(X + 1024 + (ai * HALF + wr * 64 + m * 16 + fr) * 4);
                const float inv = 1.f / ((t[0] + t[1]) + (t[2] + t[3])); bf16_t* rowp = base + (size_t)(row0 + ai * HALF + m * 16) * ldc + col0;
#pragma unroll
                for (int bj = 0; bj < 2; ++bj) { const f32x4 v0 = acc[ai][bj][m][0] * inv, v1 = acc[ai][bj][m][1] * inv;
                    u32x4 w; w.x = cvt_pk_bf16(v0[0], v0[1]); w.y = cvt_pk_bf16(v0[2], v0[3]); w.z = cvt_pk_bf16(v1[0], v1[1]); w.w = cvt_pk_bf16(v1[2], v1[3]);
                    *(u32x4*)(rowp + bj * HALF) = w; } }
        (void)mx;
    }
};

template <bool OUT_F32>
struct EpiResX {
    const bf16_t* hin; void* hout; const float* gpost; float scale; float* rsp; float* xb; unsigned* cnt; LAS float* X;
    __device__ __forceinline__ void operator()(const f32x4 (&acc)[2][2][4][2], const Unit& u, int wr, int wc, int fr, int fq) const {
        int t_ = threadIdx.x; asm volatile("" : "+v"(t_)); const int lane = t_ & 63; const int wid = __builtin_amdgcn_readfirstlane(t_ >> 6);
        LAS float* P = X; LAS float* Sx = X + 1024;
        const int grow0 = u.r + u.pm * BM; const int panel = grow0 >> 8; const int col0 = u.pn * BM + wc * 32 + 8 * fq;
        u32x4 hv[4][2];
#pragma unroll
        for (int m = 0; m < 4; ++m)
#pragma unroll
            for (int bj = 0; bj < 2; ++bj) hv[m][bj] = __builtin_nontemporal_load((const u32x4*)(hin + (size_t)(grow0 + wr * 64 + m * 16 + fr) * 1024 + col0 + bj * HALF));
#pragma unroll
        for (int ai = 0; ai < 2; ++ai)
#pragma unroll
            for (int m = 0; m < 4; ++m) { float q = 0.f;
#pragma unroll
                for (int bj = 0; bj < 2; ++bj)
#pragma unroll
                    for (int n = 0; n < 2; ++n) { const f32x4 v = acc[ai][bj][m][n]; q += (v[0] * v[0] + v[1] * v[1]) + (v[2] * v[2] + v[3] * v[3]); }
                q += __shfl_xor(q, 16); q += __shfl_xor(q, 32);
                if (fq == 0) P[(ai * HALF + wr * 64 + m * 16 + fr) * 4 + wc] = q; }
        asm volatile("s_waitcnt lgkmcnt(0)" ::: "memory"); __builtin_amdgcn_s_barrier(); asm volatile("" ::: "memory");
        const int row = wid * 32 + (lane & 31);
        if (lane < 32) { const f32x4 t = *(const LAS f32x4*)(P + row * 4);
            __hip_atomic_store(xb + (size_t)(grow0 + row) * 4 + u.pn, (t[0] + t[1]) + (t[2] + t[3]), __ATOMIC_RELAXED, __HIP_MEMORY_SCOPE_AGENT); }
        asm volatile("s_waitcnt vmcnt(0)" ::: "memory");
        if (lane == 0) __hip_atomic_fetch_add(cnt + 16 * panel, 1u, __ATOMIC_RELAXED, __HIP_MEMORY_SCOPE_AGENT);
        if (wid == 0) { unsigned sp = 0u;
            while ((unsigned)__builtin_amdgcn_readfirstlane(__hip_atomic_load(cnt + 16 * panel, __ATOMIC_RELAXED, __HIP_MEMORY_SCOPE_AGENT)) < 32u) { __builtin_amdgcn_s_sleep(2); if (++sp > (1u << 22)) break; }
            __builtin_amdgcn_fence(__ATOMIC_ACQUIRE, "agent"); }
        asm volatile("s_waitcnt vmcnt(0) lgkmcnt(0)" ::: "memory"); __builtin_amdgcn_s_barrier(); asm volatile("" ::: "memory");
        if (lane < 32) { const float* sl = xb + (size_t)(grow0 + row) * 4; float q = 0.f;
#pragma unroll
            for (int t = 0; t < 4; ++t) q += __hip_atomic_load(sl + t, __ATOMIC_RELAXED, __HIP_MEMORY_SCOPE_AGENT);
            Sx[row] = rsqrtf(q * (1.f / 1024.f) + 1e-6f) * scale; }
        asm volatile("s_waitcnt vmcnt(0) lgkmcnt(0)" ::: "memory"); __builtin_amdgcn_s_barrier(); asm volatile("" ::: "memory");
        f32x4 gg[2][2];
#pragma unroll
        for (int bj = 0; bj < 2; ++bj) { gg[bj][0] = *(const f32x4*)(gpost + col0 + bj * HALF); gg[bj][1] = *(const f32x4*)(gpost + col0 + bj * HALF + 4); }
#pragma unroll
        for (int ai = 0; ai < 2; ++ai) {
            if (ai == 1) {
#pragma unroll
                for (int m = 0; m < 4; ++m)
#pragma unroll
                    for (int bj = 0; bj < 2; ++bj) hv[m][bj] = __builtin_nontemporal_load((const u32x4*)(hin + (size_t)(grow0 + HALF + wr * 64 + m * 16 + fr) * 1024 + col0 + bj * HALF)); }
#pragma unroll
            for (int m = 0; m < 4; ++m) { const int rl = ai * HALF + wr * 64 + m * 16 + fr; const float rsf = Sx[rl]; float q = 0.f;
#pragma unroll
                for (int bj = 0; bj < 2; ++bj) { const u32x4 hw = hv[m][bj];
                    const f32x4 h0 = (f32x4){bflo(hw.x), bfhi(hw.x), bflo(hw.y), bfhi(hw.y)} + acc[ai][bj][m][0] * rsf * gg[bj][0];
                    const f32x4 h1 = (f32x4){bflo(hw.z), bfhi(hw.z), bflo(hw.w), bfhi(hw.w)} + acc[ai][bj][m][1] * rsf * gg[bj][1];
                    q += ((h0[0] * h0[0] + h0[1] * h0[1]) + (h0[2] * h0[2] + h0[3] * h0[3])) + ((h1[0] * h1[0] + h1[1] * h1[1]) + (h1[2] * h1[2] + h1[3] * h1[3]));
                    const size_t off = (size_t)(grow0 + rl) * 1024 + col0 + bj * HALF;
                    if (OUT_F32) { __builtin_nontemporal_store(h0, (f32x4*)((float*)hout + off)); __builtin_nontemporal_store(h1, (f32x4*)((float*)hout + off + 4)); }
                    else { u32x4 w; w.x = cvt_pk_bf16(h0[0], h0[1]); w.y = cvt_pk_bf16(h0[2], h0[3]); w.z = cvt_pk_bf16(h1[0], h1[1]); w.w = cvt_pk_bf16(h1[2], h1[3]); *(u32x4*)((bf16_t*)hout + off) = w; } }
                q += __shfl_xor(q, 16); q += __shfl_xor(q, 32);
                if (fq == 0) P[rl * 4 + wc] = q; } }
        asm volatile("s_waitcnt lgkmcnt(0)" ::: "memory"); __builtin_amdgcn_s_barrier(); asm volatile("" ::: "memory");
        if (rsp && lane < 32) { const f32x4 t = *(const LAS f32x4*)(P + row * 4); rsp[(size_t)(grow0 + row) * 4 + u.pn] = (t[0] + t[1]) + (t[2] + t[3]); }
    }
};

template <class Epi, bool ALIGN_EPI>
__device__ __forceinline__ void gemm_phase(LAS unsigned char* lds, const Sched& S, Epi& E) {
    int tid = threadIdx.x; asm volatile("" : "+v"(tid));
    const int wid = __builtin_amdgcn_readfirstlane(tid >> 6), lane = tid & 63, wr = wid >> 2, wc = wid & 3, fr = lane & 15, fq = lane >> 4;
    const int K = S.K, nt = K / BK;
    unsigned voffA[2], voffB[2];
#pragma unroll
    for (int i = 0; i < 2; ++i) { int R, C; stage_rc(tid * 16 + i * 8192, R, C); const int Rb = (R & ~31) + perm32(R & 31);
        voffA[i] = (unsigned)(R * S.lda + C) * 2u; voffB[i] = (unsigned)(Rb * S.ldb + C) * 2u; }
    const size_t kstep = (size_t)(BK * 2);
    const size_t hA = (size_t)HALF * S.lda * 2, hB = (size_t)HALF * S.ldb * 2;
    const unsigned ldsw = (unsigned)wid * 1024u;
    const int aoff = lds_byte(wr * 64 + fr, fq * 8), boff = lds_byte(wc * 32 + fr, fq * 8);
#define PG8_SA(b, h) (((b) * 2 + (h)) * HTB)
#define PG8_SB(b, h) ((4 + (b) * 2 + (h)) * HTB)
#define PG8_STAGE(bufoff, gbase, voff) do { _Pragma("unroll") for (int _i = 0; _i < 2; ++_i) \
        __builtin_amdgcn_global_load_lds((const unsigned*)((const char*)(gbase) + (voff)[_i]), (LAS unsigned*)(lds + (bufoff) + ldsw + _i * 8192), 16, 0, 0); } while (0)
#define PG8_LDA(dst, b, h) do { _Pragma("unroll") for (int m = 0; m < 4; ++m) _Pragma("unroll") for (int k = 0; k < 2; ++k) dst[m][k] = *(const LAS bf16x8*)(lds + PG8_SA(b, h) + aoff + m * 2048 + k * 1024); } while (0)
#define PG8_LDB(dst, b, h) do { _Pragma("unroll") for (int n = 0; n < 2; ++n) _Pragma("unroll") for (int k = 0; k < 2; ++k) dst[n][k] = *(const LAS bf16x8*)(lds + PG8_SB(b, h) + boff + n * 2048 + k * 1024); } while (0)
#define PG8_MMA(ai, bj, At, Bt) do { __builtin_amdgcn_s_setprio(1); _Pragma("unroll") for (int m = 0; m < 4; ++m) _Pragma("unroll") for (int n = 0; n < 2; ++n) _Pragma("unroll") for (int k = 0; k < 2; ++k) \
        acc[ai][bj][m][n] = __builtin_amdgcn_mfma_f32_16x16x32_bf16(Bt[n][k], At[m][k], acc[ai][bj][m][n], 0, 0, 0); __builtin_amdgcn_s_setprio(0); } while (0)
#define PG8_WAIT_V(n) asm volatile("s_waitcnt vmcnt(" #n ")" ::: "memory")
#define PG8_WAIT_L(n) asm volatile("s_waitcnt lgkmcnt(" #n ")" ::: "memory")
#define PG8_BAR __builtin_amdgcn_s_barrier()
#define PG8_SCHED __builtin_amdgcn_sched_barrier(0)
    Unit cur, nxt; int ui = 0;
    if (!S.next(0, cur)) return;
    f32x4 acc[2][2][4][2];
#pragma unroll
    for (int a = 0; a < 2; ++a)
#pragma unroll
        for (int b = 0; b < 2; ++b)
#pragma unroll
            for (int m = 0; m < 4; ++m)
#pragma unroll
                for (int n = 0; n < 2; ++n) acc[a][b][m][n] = (f32x4){0.f, 0.f, 0.f, 0.f};
    bf16x8 At[4][2], B0[2][2], B1[2][2];
    const char* cA = cur.a; const char* cB = cur.b;
    PG8_STAGE(PG8_SB(0, 0), cB, voffB); PG8_STAGE(PG8_SB(0, 1), cB + hB, voffB); PG8_STAGE(PG8_SA(0, 0), cA, voffA); PG8_STAGE(PG8_SA(0, 1), cA + hA, voffA);
    if (wr == 1) PG8_BAR;
    PG8_WAIT_V(2); PG8_BAR;
    PG8_STAGE(PG8_SB(1, 0), cB + kstep, voffB); PG8_STAGE(PG8_SA(1, 0), cA + kstep, voffA); PG8_STAGE(PG8_SB(1, 1), cB + hB + kstep, voffB);
    PG8_WAIT_V(6); PG8_BAR;
    for (;;) {
        const bool has_next = S.next(ui + 1, nxt);
        const char* nA = has_next ? nxt.a : cA; const char* nB = has_next ? nxt.b : cB;
        for (int t = 0; t < nt; t += 2) {
            const bool last = (t == nt - 2);
            const char* a1 = cA + (size_t)(t + 1) * kstep;
            const char* a2 = last ? nA : cA + (size_t)(t + 2) * kstep; const char* b2 = last ? nB : cB + (size_t)(t + 2) * kstep;
            const char* a3 = a2 + kstep; const char* b3 = b2 + kstep;
            PG8_LDB(B0, 0, 0); PG8_LDB(B1, 0, 1); PG8_SCHED; PG8_LDA(At, 0, 0); PG8_STAGE(PG8_SA(1, 1), a1 + hA, voffA);
            PG8_WAIT_V(8); PG8_WAIT_L(0); PG8_BAR; PG8_MMA(0, 0, At, B0); PG8_MMA(0, 1, At, B1); PG8_BAR; PG8_SCHED;
            PG8_LDA(At, 0, 1); PG8_STAGE(PG8_SB(0, 0), b2, voffB); PG8_STAGE(PG8_SB(0, 1), b2 + hB, voffB); PG8_STAGE(PG8_SA(0, 0), a2, voffA);
            PG8_WAIT_V(8); PG8_WAIT_L(0); PG8_BAR; PG8_MMA(1, 0, At, B0); PG8_MMA(1, 1, At, B1); PG8_BAR; PG8_SCHED;
            PG8_LDB(B0, 1, 0); PG8_LDB(B1, 1, 1); PG8_SCHED; PG8_LDA(At, 1, 0); PG8_STAGE(PG8_SA(0, 1), a2 + hA, voffA);
            PG8_WAIT_V(8); PG8_WAIT_L(0); PG8_BAR; PG8_MMA(0, 0, At, B0); PG8_MMA(0, 1, At, B1); PG8_BAR; PG8_SCHED;
            PG8_LDA(At, 1, 1); PG8_STAGE(PG8_SB(1, 0), b3, voffB); PG8_STAGE(PG8_SB(1, 1), b3 + hB, voffB); PG8_STAGE(PG8_SA(1, 0), a3, voffA);
            PG8_WAIT_V(8); PG8_WAIT_L(0); PG8_BAR; PG8_MMA(1, 0, At, B0); PG8_MMA(1, 1, At, B1); PG8_BAR; PG8_SCHED;
        }
        if constexpr (ALIGN_EPI) { if (wr == 0) PG8_BAR; }
        E(acc, cur, wr, wc, fr, fq);
        if (!has_next) break;
#pragma unroll
        for (int a = 0; a < 2; ++a)
#pragma unroll
            for (int b = 0; b < 2; ++b)
#pragma unroll
                for (int m = 0; m < 4; ++m)
#pragma unroll
                    for (int n = 0; n < 2; ++n) acc[a][b][m][n] = (f32x4){0.f, 0.f, 0.f, 0.f};
        cur = nxt; cA = nA; cB = nB; ++ui;
        if constexpr (ALIGN_EPI) { if (wr == 1) PG8_BAR; }
    }
    PG8_WAIT_V(0);
    if constexpr (!ALIGN_EPI) { if (wr == 0) PG8_BAR; }
    PG8_BAR;
#undef PG8_SA
#undef PG8_SB
#undef PG8_STAGE
#undef PG8_LDA
#undef PG8_LDB
#undef PG8_MMA
#undef PG8_WAIT_V
#undef PG8_WAIT_L
#undef PG8_BAR
#undef PG8_SCHED
}
}

struct Args {
    const float* in[27]; float* out; unsigned char* ws;
};
enum { I_X = 0, I_MEM, I_F1PRE, I_F1WGU, I_F1WD, I_F1POST, I_MIXPRE, I_WIN, I_CONVW, I_CONVB, I_DTB, I_ALOG, I_DSKIP, I_SSDG, I_ATTG, I_WOUT, I_MIXPOST,
       I_XAPRE, I_MEMG, I_XAWQ, I_XAWKV, I_XAWO, I_XAPOST, I_F2PRE, I_F2WGU, I_F2WD, I_F2POST };

__device__ __forceinline__ int opaque_tid() { int t = threadIdx.x; asm volatile("" : "+v"(t)); return t; }
__device__ __forceinline__ int dest_row(int mode, int n0) {
    if (mode == 0) return n0;
    if (mode == 1) { const int bj = n0 / DFF, f = n0 % DFF; return 256 * (f / 128) + 128 * bj + (f % 128); }
    if (n0 < 1024) return n0; if (n0 < 2048) return n0 + 1024; if (n0 < 3072) return n0 + 1024; if (n0 < 4096) return n0 - 2048; return n0;
}
__device__ __forceinline__ void transpose_item(const float* W, int K, int Npitch, int nblk, bf16_t* WT, int mode, LAS float* scr, int item, int lane, const float* gk = nullptr) {
    const int kb = item / nblk, nb = item % nblk, k0 = 64 * kb, n0 = 32 * nb;
    float wv[32];
#pragma unroll
    for (int i = 0; i < 32; ++i) { const int kk = 2 * i + (lane >> 5); wv[i] = __builtin_nontemporal_load(W + (size_t)(k0 + kk) * Npitch + n0 + (lane & 31)); }
#pragma unroll
    for (int i = 0; i < 32; ++i) { const int kk = 2 * i + (lane >> 5); scr[kk * 33 + (lane & 31)] = gk ? wv[i] * gk[k0 + kk] : wv[i]; }
    asm volatile("s_waitcnt lgkmcnt(0)" ::: "memory");
    const int c = lane & 7; const int dr = dest_row(mode, n0);
#pragma unroll
    for (int j = 0; j < 4; ++j) { const int n = (lane >> 3) + 8 * j; const LAS float* s = scr + (8 * c) * 33 + n;
        u32x4 o; o.x = pk2(s[0 * 33], s[1 * 33]); o.y = pk2(s[2 * 33], s[3 * 33]); o.z = pk2(s[4 * 33], s[5 * 33]); o.w = pk2(s[6 * 33], s[7 * 33]);
        *(u32x4*)(WT + (size_t)(dr + n) * K + k0 + 8 * c) = o; }
    asm volatile("s_waitcnt lgkmcnt(0)" ::: "memory");
}
__device__ __forceinline__ void rms_rows_phase(const float* X, const float* g, bf16_t* O, int nrows, int gw, int NGW, int lane, float* RSout = nullptr) {
    f32x4 gg[4];
#pragma unroll
    for (int j = 0; j < 4; ++j) gg[j] = RSout ? (f32x4){1.f, 1.f, 1.f, 1.f} : ((const f32x4*)g)[lane + 64 * j];
    f32x4 a[4], n[4]; int m = gw;
    if (m < nrows) {
#pragma unroll
        for (int j = 0; j < 4; ++j) a[j] = __builtin_nontemporal_load((const f32x4*)(X + (size_t)m * DM) + lane + 64 * j); }
    for (; m < nrows; m += NGW) {
        const int mn = m + NGW;
        if (mn < nrows) {
#pragma unroll
            for (int j = 0; j < 4; ++j) n[j] = __builtin_nontemporal_load((const f32x4*)(X + (size_t)mn * DM) + lane + 64 * j); }
        float s = 0.f;
#pragma unroll
        for (int j = 0; j < 4; ++j) s += (a[j].x * a[j].x + a[j].y * a[j].y) + (a[j].z * a[j].z + a[j].w * a[j].w);
        float rs = rsqrtf(wave_sum(s) * (1.f / DM) + EPS);
        if (RSout) { if (lane == 0) RSout[m] = rs; rs = 1.f; }
        u32x2* o8 = (u32x2*)(O + (size_t)m * DM) + lane;
#pragma unroll
        for (int j = 0; j < 4; ++j) { u32x2 w; w.x = pk2(a[j].x * rs * gg[j].x, a[j].y * rs * gg[j].y); w.y = pk2(a[j].z * rs * gg[j].z, a[j].w * rs * gg[j].w); o8[64 * j] = w; }
#pragma unroll
        for (int j = 0; j < 4; ++j) a[j] = n[j];
    }
}
template <bool HIN_BF16, bool HOUT_BF16>
__device__ __forceinline__ void res_rows_phase(const bf16_t* F, const void* hin_, const float* gpost, float scale, void* hout_, float* RSout, int gw, int NGW, int lane) {
    f32x4 gp[4];
#pragma unroll
    for (int j = 0; j < 4; ++j) gp[j] = ((const f32x4*)gpost)[lane + 64 * j];
    u32x2 fa[4], fn[4]; f32x4 ha[4], hn[4]; int m = gw;
#define RR_LOADH(dst, row) do { if (HIN_BF16) { _Pragma("unroll") for (int j = 0; j < 4; ++j) { const u32x2 w_ = ((const u32x2*)((const bf16_t*)hin_ + (size_t)(row) * DM))[lane + 64 * j]; dst[j] = (f32x4){bflo(w_.x), bfhi(w_.x), bflo(w_.y), bfhi(w_.y)}; } } \
        else { _Pragma("unroll") for (int j = 0; j < 4; ++j) dst[j] = ((const f32x4*)((const float*)hin_ + (size_t)(row) * DM))[lane + 64 * j]; } } while (0)
    if (m < MTOK) {
#pragma unroll
        for (int j = 0; j < 4; ++j) fa[j] = ((const u32x2*)(F + (size_t)m * DM))[lane + 64 * j];
        RR_LOADH(ha, m); }
    for (; m < MTOK; m += NGW) {
        const int mn = m + NGW;
        if (mn < MTOK) {
#pragma unroll
            for (int j = 0; j < 4; ++j) fn[j] = ((const u32x2*)(F + (size_t)mn * DM))[lane + 64 * j];
            RR_LOADH(hn, mn); }
        f32x4 f[4]; float s = 0.f;
#pragma unroll
        for (int j = 0; j < 4; ++j) { f[j] = (f32x4){bflo(fa[j].x), bfhi(fa[j].x), bflo(fa[j].y), bfhi(fa[j].y)}; s += (f[j].x * f[j].x + f[j].y * f[j].y) + (f[j].z * f[j].z + f[j].w * f[j].w); }
        const float rs = rsqrtf(wave_sum(s) * (1.f / DM) + EPS) * scale; float s2 = 0.f;
#pragma unroll
        for (int j = 0; j < 4; ++j) { f[j] = ha[j] + f[j] * rs * gp[j];
            if (HOUT_BF16) { u32x2 w; w.x = pk2(f[j].x, f[j].y); w.y = pk2(f[j].z, f[j].w); ((u32x2*)((bf16_t*)hout_ + (size_t)m * DM))[lane + 64 * j] = w; }
            else ((f32x4*)((float*)hout_ + (size_t)m * DM))[lane + 64 * j] = f[j];
            s2 += (f[j].x * f[j].x + f[j].y * f[j].y) + (f[j].z * f[j].z + f[j].w * f[j].w); }
        if (RSout) { const float rs2 = rsqrtf(wave_sum(s2) * (1.f / DM) + EPS); if (lane == 0) RSout[m] = rs2; }
#pragma unroll
        for (int j = 0; j < 4; ++j) { fa[j] = fn[j]; ha[j] = hn[j]; }
    }
#undef RR_LOADH
}
__device__ __forceinline__ void mixnorm_phase(bf16_t* PROJ, const float* attg, const float* ssdg, int gw, int NGW, int lane) {
    f32x4 g0[4], g1[4];
#pragma unroll
    for (int j = 0; j < 4; ++j) { const float* g = (j < 2 ? attg + 512 * j : ssdg + 512 * (j - 2)) + 8 * lane; g0[j] = *(const f32x4*)g; g1[j] = *(const f32x4*)(g + 4); }
    u32x4 a[4], n[4]; int m = gw;
    if (m < MTOK) {
#pragma unroll
        for (int j = 0; j < 4; ++j) a[j] = ((const u32x4*)(PROJ + (size_t)m * LDP))[lane + 64 * j]; }
    for (; m < MTOK; m += NGW) {
        const int mn = m + NGW;
        if (mn < MTOK) {
#pragma unroll
            for (int j = 0; j < 4; ++j) n[j] = ((const u32x4*)(PROJ + (size_t)mn * LDP))[lane + 64 * j]; }
        float v[4][8]; float ss[4];
#pragma unroll
        for (int j = 0; j < 4; ++j) { const u32x4 w = a[j]; v[j][0] = bflo(w.x); v[j][1] = bfhi(w.x); v[j][2] = bflo(w.y); v[j][3] = bfhi(w.y); v[j][4] = bflo(w.z); v[j][5] = bfhi(w.z); v[j][6] = bflo(w.w); v[j][7] = bfhi(w.w);
            float s = 0.f;
#pragma unroll
            for (int i = 0; i < 8; ++i) s += v[j][i] * v[j][i];
            ss[j] = wave_sum(s); }
        const float rsa = rsqrtf((ss[0] + ss[1]) * (1.f / 1024.f) + EPS), rs0 = rsqrtf(ss[2] * (1.f / 512.f) + EPS), rs1 = rsqrtf(ss[3] * (1.f / 512.f) + EPS);
        u32x4* p = (u32x4*)(PROJ + (size_t)m * LDP) + lane;
#pragma unroll
        for (int j = 0; j < 4; ++j) { const float rs = j < 2 ? rsa : (j == 2 ? rs0 : rs1);
            u32x4 w; w.x = pk2(v[j][0] * rs * g0[j].x, v[j][1] * rs * g0[j].y); w.y = pk2(v[j][2] * rs * g0[j].z, v[j][3] * rs * g0[j].w); w.z = pk2(v[j][4] * rs * g1[j].x, v[j][5] * rs * g1[j].y); w.w = pk2(v[j][6] * rs * g1[j].z, v[j][7] * rs * g1[j].w);
            p[64 * j] = w; }
#pragma unroll
        for (int j = 0; j < 4; ++j) a[j] = n[j];
    }
}

constexpr int AT_STR = 72;
constexpr float SB_THR = 20.f;
__device__ __forceinline__ void attn_phase(bf16_t* PROJ, bf16_t* Odst, int opitch, int ocol, LAS unsigned char* lds, int bid, int G) {
    int tid = threadIdx.x; asm volatile("" : "+v"(tid)); const int lane = tid & 63; const int wid = __builtin_amdgcn_readfirstlane(tid >> 6);
    const int r32 = lane & 31, hi = lane >> 5;
    LAS bf16_t* VTs = (LAS bf16_t*)(lds + wid * (64 * AT_STR * 2));
    LAS bf16_t* Kt = (LAS bf16_t*)(lds + 8 * (64 * AT_STR * 2) + wid * 8192);
    const int vc = lane & 7, vp = lane >> 3;
    bf16x8 qn[4], kf[8]; u32x4 vr[8];
#define AT_DECODE(u_, b_, h_, qbase_) do { const int qb_ = 15 - ((u_) & 15), bh_ = (u_) >> 4; b_ = bh_ >> 4; h_ = bh_ & 15; qbase_ = qb_ * 256 + 32 * wid; } while (0)
#define AT_LOAD(b_, h_, t) do { int vp_ = vp, vc_ = vc; asm volatile("" : "+v"(vp_), "+v"(vc_));        \
        const bf16_t* Kl_ = PROJ + ((size_t)(b_) * SEQ + vp_) * LDP + PK + (h_) * 64 + 8 * vc_; const bf16_t* Vl_ = PROJ + ((size_t)(b_) * SEQ + 2 * vp_) * LDP + PV + (h_) * 64 + 8 * vc_; \
        _Pragma("unroll") for (int i_ = 0; i_ < 8; ++i_) kf[i_] = *(const bf16x8*)(Kl_ + (size_t)(64 * (t) + 8 * i_) * LDP); \
        _Pragma("unroll") for (int j_ = 0; j_ < 4; ++j_) { vr[2 * j_] = *(const u32x4*)(Vl_ + (size_t)(64 * (t) + 16 * j_) * LDP); vr[2 * j_ + 1] = *(const u32x4*)(Vl_ + (size_t)(64 * (t) + 16 * j_ + 1) * LDP); } } while (0)
#define AT_LOADQ(b_, h_, qbase_) do { const bf16_t* Qp_ = PROJ + ((size_t)(b_) * SEQ + (qbase_) + r32) * LDP + PQ + (h_) * 64 + 8 * hi; _Pragma("unroll") for (int d_ = 0; d_ < 4; ++d_) qn[d_] = *(const bf16x8*)(Qp_ + 16 * d_); } while (0)
    int u = bid;
    if (u >= 2048) return;
    int b, h, qbase; AT_DECODE(u, b, h, qbase);
    AT_LOADQ(b, h, qbase); AT_LOAD(b, h, (qbase + 30) >> 6);
    for (; u < 2048; u += G) {
        AT_DECODE(u, b, h, qbase);
        const int un = u + G; int bn = 0, hn = 0, qbn = 0; if (un < 2048) AT_DECODE(un, bn, hn, qbn);
        const int myq = qbase + r32; const int wqmax = qbase + 31;
        bf16x8 qr[4];
#pragma unroll
        for (int d0 = 0; d0 < 4; ++d0) qr[d0] = qn[d0];
        f32x16 o0, o1;
#pragma unroll
        for (int r = 0; r < 16; ++r) { o0[r] = 0.f; o1[r] = 0.f; }
        float R = 0.f;
        int jt = (qbase + 30) >> 6;
        for (;;) {
            int vck = vc, vpk = vp, r32k = r32; asm volatile("" : "+v"(vck), "+v"(vpk), "+v"(r32k));
#pragma unroll
            for (int i = 0; i < 8; ++i) *(LAS bf16x8*)(Kt + (8 * i + vpk) * 64 + 8 * (vck ^ ((4 * (i & 1) + (vpk >> 1)) & 7))) = kf[i];
            { LAS unsigned* vt32 = (LAS unsigned*)VTs;
#pragma unroll
              for (int j = 0; j < 4; ++j) { const u32x4 A = vr[2 * j], B = vr[2 * j + 1]; LAS unsigned* d = vt32 + ((8 * vc) * AT_STR + 2 * ((vp + 8 * j) ^ (4 * vc))) / 2;
                  d[0 * (AT_STR / 2)] = (A.x & 0xffffu) | (B.x << 16); d[1 * (AT_STR / 2)] = (A.x >> 16) | (B.x & 0xffff0000u);
                  d[2 * (AT_STR / 2)] = (A.y & 0xffffu) | (B.y << 16); d[3 * (AT_STR / 2)] = (A.y >> 16) | (B.y & 0xffff0000u);
                  d[4 * (AT_STR / 2)] = (A.z & 0xffffu) | (B.z << 16); d[5 * (AT_STR / 2)] = (A.z >> 16) | (B.z & 0xffff0000u);
                  d[6 * (AT_STR / 2)] = (A.w & 0xffffu) | (B.w << 16); d[7 * (AT_STR / 2)] = (A.w >> 16) | (B.w & 0xffff0000u); } }
            const bool pred_last = (jt == 0) || (64 * jt + 64 <= qbase);
            if (pred_last) { if (un < 2048) { AT_LOADQ(bn, hn, qbn); AT_LOAD(bn, hn, (qbn + 30) >> 6); } }
            else AT_LOAD(b, h, jt - 1);
#pragma unroll
            for (int sub = 1; sub >= 0; --sub) {
                const int kbase = 64 * jt + 32 * sub;
                if (kbase < wqmax && !(sub == 0 && __all(R >= SB_THR * 1.4426950408889634f))) {
                    f32x16 s;
#pragma unroll
                    for (int r = 0; r < 16; ++r) s[r] = 0.f;
#pragma unroll
                    for (int d0 = 0; d0 < 4; ++d0) { const bf16x8 kfr = *(const LAS bf16x8*)(Kt + (32 * sub + r32k) * 64 + 8 * ((2 * d0 + hi) ^ ((r32k >> 1) & 7)));
                        s = __builtin_amdgcn_mfma_f32_32x32x16_bf16(kfr, qr[d0], s, 0, 0, 0); }
                    float sp[16], T[4], U[4];
                    if (kbase + 31 >= qbase) {
#pragma unroll
                        for (int r = 0; r < 16; ++r) { const int key = kbase + crow(r, hi); const float zl = s[r] * (0.125f * 1.4426950408889634f);
                            const float v = fmaxf(zl, 0.f) + __builtin_amdgcn_logf(1.f + __builtin_amdgcn_exp2f(-fabsf(zl)));
                            const bool ok = key < myq; s[r] = ok ? zl : -1.0e30f; sp[r] = ok ? v : 0.f; }
                    } else {
#pragma unroll
                        for (int r = 0; r < 16; ++r) { const float zl = s[r] * (0.125f * 1.4426950408889634f); s[r] = zl;
                            sp[r] = fmaxf(zl, 0.f) + __builtin_amdgcn_logf(1.f + __builtin_amdgcn_exp2f(-fabsf(zl))); }
                    }
#pragma unroll
                    for (int g = 0; g < 4; ++g) { T[g] = (sp[4 * g] + sp[4 * g + 1]) + (sp[4 * g + 2] + sp[4 * g + 3]); U[g] = __shfl_xor(T[g], 32); }
                    float tail = 0.f; float a[16];
#pragma unroll
                    for (int g = 3; g >= 0; --g) { float run = R + tail + (hi == 0 ? U[g] : 0.f);
#pragma unroll
                        for (int e = 3; e >= 0; --e) { const int r = 4 * g + e; run += sp[r]; a[r] = __builtin_amdgcn_exp2f(s[r] - run); }
                        tail += T[g] + U[g]; }
                    R += tail;
                    bf16x8 pf[2];
#pragma unroll
                    for (int s2 = 0; s2 < 2; ++s2) { u32x4 w; w.x = pk2(a[8 * s2], a[8 * s2 + 1]); w.y = pk2(a[8 * s2 + 2], a[8 * s2 + 3]); w.z = pk2(a[8 * s2 + 4], a[8 * s2 + 5]); w.w = pk2(a[8 * s2 + 6], a[8 * s2 + 7]); pf[s2] = __builtin_bit_cast(bf16x8, w); }
#pragma unroll
                    for (int s2 = 0; s2 < 2; ++s2)
#pragma unroll
                        for (int dd = 0; dd < 2; ++dd) { const LAS bf16_t* vrow = VTs + r32k * AT_STR + 4 * hi + dd * 32 * AT_STR + 32 * (sub ^ dd);
                            const bf16x4 lo = *(const LAS bf16x4*)(vrow + ((8 * (r32k >> 3)) ^ (16 * s2))), hi4 = *(const LAS bf16x4*)(vrow + ((8 * (r32k >> 3)) ^ (16 * s2 + 8)));
                            const bf16x8 vf = (bf16x8){lo[0], lo[1], lo[2], lo[3], hi4[0], hi4[1], hi4[2], hi4[3]};
                            if (dd == 0) o0 = __builtin_amdgcn_mfma_f32_32x32x16_bf16(pf[s2], vf, o0, 0, 0, 0); else o1 = __builtin_amdgcn_mfma_f32_32x32x16_bf16(pf[s2], vf, o1, 0, 0, 0); }
                }
            }
            const bool done = (jt == 0) || (__all(R >= SB_THR * 1.4426950408889634f) != 0);
            if (done) { if (!pred_last && un < 2048) { AT_LOADQ(bn, hn, qbn); AT_LOAD(bn, hn, (qbn + 30) >> 6); } break; }
            if (pred_last) AT_LOAD(b, h, jt - 1);
            --jt;
        }
        { bf16_t* Op = Odst + ((size_t)b * SEQ + qbase) * opitch + ocol + h * 64 + r32;
#pragma unroll
          for (int r = 0; r < 16; ++r) { bf16_t* p = Op + (size_t)crow(r, hi) * opitch; p[0] = (bf16_t)f2bf(o0[r]); p[32] = (bf16_t)f2bf(o1[r]); } }
    }
#undef AT_LOAD
#undef AT_LOADQ
#undef AT_DECODE
}

constexpr int SS = 136;
constexpr int L_CS = 0, L_BS = 128 * SS * 2, L_BDT = 2 * 128 * SS * 2, L_XT = 3 * 128 * SS * 2, L_DT = L_XT + 64 * SS * 2, L_ACS = L_DT + 512, L_SSD_END = L_ACS + 512;
static_assert(L_SSD_END <= 131072, "ssd lds");
__device__ __forceinline__ void conv8(const bf16_t* PROJ, size_t T, int tl, int ch, const float* convw, const float* convb, float (&o)[8]) {
    { const f32x4 b0 = *(const f32x4*)(convb + ch), b1 = *(const f32x4*)(convb + ch + 4); o[0] = b0.x; o[1] = b0.y; o[2] = b0.z; o[3] = b0.w; o[4] = b1.x; o[5] = b1.y; o[6] = b1.z; o[7] = b1.w; }
    u32x4 w[4];
#pragma unroll
    for (int k = 0; k < 4; ++k) { const int tk = tl - 3 + k; const int tc = tk < 0 ? 0 : tk;
        w[k] = *(const u32x4*)(PROJ + (T - tl + tc) * LDP + PX + ch); const unsigned mk = tk < 0 ? 0u : 0xffffffffu; w[k].x &= mk; w[k].y &= mk; w[k].z &= mk; w[k].w &= mk; }
#pragma unroll
    for (int k = 0; k < 4; ++k) { const f32x4 w0 = *(const f32x4*)(convw + k * 1536 + ch), w1 = *(const f32x4*)(convw + k * 1536 + ch + 4);
        o[0] += bflo(w[k].x) * w0.x; o[1] += bfhi(w[k].x) * w0.y; o[2] += bflo(w[k].y) * w0.z; o[3] += bfhi(w[k].y) * w0.w;
        o[4] += bflo(w[k].z) * w1.x; o[5] += bfhi(w[k].z) * w1.y; o[6] += bflo(w[k].w) * w1.z; o[7] += bfhi(w[k].w) * w1.w; }
#pragma unroll
    for (int i = 0; i < 8; ++i) o[i] = silu_f(o[i]);
}
__device__ __forceinline__ void dt_acs(const float* DT, size_t T0, int h, float dbias, float Aneg, int lane, LAS float* dtL, LAS float* acsL) {
    const float d0 = softplus_f(DT[(T0 + lane) * 16 + h] + dbias), d1 = softplus_f(DT[(T0 + 64 + lane) * 16 + h] + dbias);
    float s0 = d0 * Aneg, s1 = d1 * Aneg;
#pragma unroll
    for (int o = 1; o < 64; o <<= 1) { const float t0 = __shfl_up(s0, o), t1 = __shfl_up(s1, o); if (lane >= o) { s0 += t0; s1 += t1; } }
    const float tot0 = __shfl(s0, 63); s1 += tot0;
    dtL[lane] = d0; dtL[64 + lane] = d1; acsL[lane] = s0; acsL[64 + lane] = s1;
}
__device__ __forceinline__ bf16_t* state_ptr(bf16_t* ST, size_t T0, int h, int n, int p) { return ST + ((T0 >> 7) * 16 + h) * 8192 + n * 64 + p; }

#define LDS_BAR() do { asm volatile("s_waitcnt lgkmcnt(0)" ::: "memory"); __builtin_amdgcn_s_barrier(); asm volatile("" ::: "memory"); } while (0)
struct ConvW { f32x4 cw[8]; f32x4 b0, b1; };
__device__ __forceinline__ void convw_load(ConvW& W, int ch, const float* convw, const float* convb) {
    W.b0 = *(const f32x4*)(convb + ch); W.b1 = *(const f32x4*)(convb + ch + 4);
#pragma unroll
    for (int k = 0; k < 4; ++k) { W.cw[2 * k] = *(const f32x4*)(convw + k * 1536 + ch); W.cw[2 * k + 1] = *(const f32x4*)(convw + k * 1536 + ch + 4); }
}
__device__ __forceinline__ void conv_raw_load(u32x4 (&w)[4], const bf16_t* PROJ, size_t T, int tl, int ch) {
#pragma unroll
    for (int k = 0; k < 4; ++k) { const int tk = tl - 3 + k; const int tc = tk < 0 ? 0 : tk;
        w[k] = *(const u32x4*)(PROJ + (T - tl + tc) * LDP + PX + ch); const unsigned mk = tk < 0 ? 0u : 0xffffffffu; w[k].x &= mk; w[k].y &= mk; w[k].z &= mk; w[k].w &= mk; }
}
__device__ __forceinline__ void conv_compute(const u32x4 (&w)[4], const ConvW& W, float (&o)[8]) {
    o[0] = W.b0.x; o[1] = W.b0.y; o[2] = W.b0.z; o[3] = W.b0.w; o[4] = W.b1.x; o[5] = W.b1.y; o[6] = W.b1.z; o[7] = W.b1.w;
#pragma unroll
    for (int k = 0; k < 4; ++k) { const f32x4 w0 = W.cw[2 * k], w1 = W.cw[2 * k + 1];
        o[0] += bflo(w[k].x) * w0.x; o[1] += bfhi(w[k].x) * w0.y; o[2] += bflo(w[k].y) * w0.z; o[3] += bfhi(w[k].y) * w0.w;
        o[4] += bflo(w[k].z) * w1.x; o[5] += bfhi(w[k].z) * w1.y; o[6] += bflo(w[k].w) * w1.z; o[7] += bfhi(w[k].w) * w1.w; }
#pragma unroll
    for (int i = 0; i < 8; ++i) o[i] = silu_f(o[i]);
}
constexpr int LA_DT = L_XT + 64 * SS * 2, LA_ACS = LA_DT + 4096, LA_END = LA_ACS + 4096;
static_assert(LA_END <= 131072, "ssd A lds");
__device__ __forceinline__ void ssdA_unit(int u, bf16_t* PROJ, bf16_t* ST, bf16_t* YP, float* CD, const float* DT, const float* convw, const float* convb, const float* dtb, const float* alog, const float* dskip, LAS unsigned char* lds) {
    int tid = threadIdx.x; asm volatile("" : "+v"(tid)); const int lane = tid & 63, r32 = lane & 31, hi = lane >> 5; const int wid = __builtin_amdgcn_readfirstlane(tid >> 6);
    const int b = u >> 6, c = (u >> 1) & 31, g = u & 1;
    LAS bf16_t* Cs = (LAS bf16_t*)(lds + L_CS); LAS bf16_t* Bs = (LAS bf16_t*)(lds + L_BS); LAS bf16_t* BdT = (LAS bf16_t*)(lds + L_BDT);
    LAS bf16_t* XT = (LAS bf16_t*)(lds + L_XT); LAS float* dtL8 = (LAS float*)(lds + LA_DT); LAS float* acsL8 = (LAS float*)(lds + LA_ACS); LAS bf16_t* Mm = Cs;
    const size_t T0 = (size_t)b * SEQ + (size_t)c * 128;
    const int nb = wid >> 1, pb = wid & 1;
    const int xl = tid >> 3, xv = tid & 7;
    { const int h = 8 * g + wid; dt_acs(DT, T0, h, dtb[h], -__expf(alog[h]), lane, dtL8 + wid * 128, acsL8 + wid * 128); }
    { ConvW W; const int v = tid & 31; const int ch = (v < 16) ? 1024 + g * 128 + v * 8 : 1280 + g * 128 + (v - 16) * 8; convw_load(W, ch, convw, convb);
      LAS bf16_t* dst0 = (v < 16) ? (Bs + v * 8) : (Cs + (v - 16) * 8);
#pragma unroll
      for (int jj = 0; jj < 2; ++jj) { u32x4 raw[4][4];
#pragma unroll
          for (int j = 0; j < 4; ++j) { const int l = (tid >> 5) + 16 * (4 * jj + j); conv_raw_load(raw[j], PROJ, T0 + l, c * 128 + l, ch); }
#pragma unroll
          for (int j = 0; j < 4; ++j) { const int l = (tid >> 5) + 16 * (4 * jj + j); float o[8]; conv_compute(raw[j], W, o);
              u32x4 w; w.x = pk2(o[0], o[1]); w.y = pk2(o[2], o[3]); w.z = pk2(o[4], o[5]); w.w = pk2(o[6], o[7]); *(LAS u32x4*)(dst0 + l * SS) = w; } } }
    u32x4 raw0[4], raw1[4]; ConvW XW;
    conv_raw_load(raw0, PROJ, T0 + xl, c * 128 + xl, 8 * g * 64 + xv * 8); conv_raw_load(raw1, PROJ, T0 + xl + 64, c * 128 + xl + 64, 8 * g * 64 + xv * 8); convw_load(XW, 8 * g * 64 + xv * 8, convw, convb);
    LDS_BAR();
    f32x16 cb[2];
#pragma unroll
    for (int r = 0; r < 16; ++r) { cb[0][r] = 0.f; cb[1][r] = 0.f; }
#pragma unroll
    for (int t = 0; t < 2; ++t) { const int id = wid + 8 * t, lb = id >> 2, sb = id & 3;
        if (sb <= lb) {
#pragma unroll
            for (int ks = 0; ks < 8; ++ks) { const bf16x8 af = *(const LAS bf16x8*)(Cs + (32 * lb + r32) * SS + 16 * ks + 8 * hi), bf = *(const LAS bf16x8*)(Bs + (32 * sb + r32) * SS + 16 * ks + 8 * hi);
                cb[t] = __builtin_amdgcn_mfma_f32_32x32x16_bf16(af, bf, cb[t], 0, 0, 0); } } }
    LDS_BAR();
#pragma unroll 1
    for (int r8 = 0; r8 < 8; ++r8) {
        const int h = 8 * g + r8; const float dsk = dskip[h];
        int r32v = r32, hiv = hi; asm volatile("" : "+v"(r32v), "+v"(hiv));
        LAS float* dtL = dtL8 + r8 * 128; LAS float* acsL = acsL8 + r8 * 128;
        { float o[8]; conv_compute(raw0, XW, o); LAS bf16_t* xd = XT + (xv * 8) * SS + (xl ^ (8 * xv));
#pragma unroll
          for (int i = 0; i < 8; ++i) xd[i * SS] = (bf16_t)f2bf(o[i]);
          conv_compute(raw1, XW, o); xd += 64;
#pragma unroll
          for (int i = 0; i < 8; ++i) xd[i * SS] = (bf16_t)f2bf(o[i]); }
        LDS_BAR();
        if (r8 < 7) { const int ch = (h + 1) * 64 + xv * 8; conv_raw_load(raw0, PROJ, T0 + xl, c * 128 + xl, ch); conv_raw_load(raw1, PROJ, T0 + xl + 64, c * 128 + xl + 64, ch); convw_load(XW, ch, convw, convb); }
        { const float alast = acsL[127];
#pragma unroll 1
          for (int it = tid; it < 128 * 16; it += 512) { const int l = it >> 4, nv = it & 15; const float wl = dtL[l] * __expf(alast - acsL[l]);
              const u32x4 w = *(const LAS u32x4*)(Bs + l * SS + nv * 8); LAS bf16_t* d = BdT + (nv * 8) * SS + (l ^ (8 * nv));
              d[0 * SS] = (bf16_t)f2bf(bflo(w.x) * wl); d[1 * SS] = (bf16_t)f2bf(bfhi(w.x) * wl); d[2 * SS] = (bf16_t)f2bf(bflo(w.y) * wl); d[3 * SS] = (bf16_t)f2bf(bfhi(w.y) * wl);
              d[4 * SS] = (bf16_t)f2bf(bflo(w.z) * wl); d[5 * SS] = (bf16_t)f2bf(bfhi(w.z) * wl); d[6 * SS] = (bf16_t)f2bf(bflo(w.w) * wl); d[7 * SS] = (bf16_t)f2bf(bfhi(w.w) * wl); }
          if (tid == 0) CD[(b * 16 + h) * 32 + c] = __expf(alast); }
#pragma unroll
        for (int t = 0; t < 2; ++t) { const int id = wid + 8 * t, lb = id >> 2, sb = id & 3;
            if (sb <= lb) { const int sidx = 32 * sb + r32v; const float as = acsL[sidx], ds = dtL[sidx];
#pragma unroll
                for (int r = 0; r < 16; ++r) { const int l = 32 * lb + crow(r, hiv); const float e = __expf(fminf(acsL[l] - as, 0.f)) * ((sidx <= l) ? ds : 0.f); Mm[l * SS + sidx] = (bf16_t)f2bf(cb[t][r] * e); } } }
        LDS_BAR();
        { f32x16 st, yd;
#pragma unroll
          for (int r = 0; r < 16; ++r) { st[r] = 0.f; yd[r] = 0.f; }
#pragma unroll
          for (int ks = 0; ks < 8; ++ks) { const bf16x8 af = *(const LAS bf16x8*)(BdT + (32 * nb + r32v) * SS + ((16 * ks + 8 * hiv) ^ ((32 * nb + r32v) & 120))), bf = *(const LAS bf16x8*)(XT + (32 * pb + r32v) * SS + ((16 * ks + 8 * hiv) ^ ((32 * pb + r32v) & 56)));
              st = __builtin_amdgcn_mfma_f32_32x32x16_bf16(af, bf, st, 0, 0, 0); }
          const int lb = nb;
#pragma unroll
          for (int ks = 0; ks < 8; ++ks) { if (ks < 2 * (lb + 1)) { const bf16x8 af = *(const LAS bf16x8*)(Mm + (32 * lb + r32v) * SS + 16 * ks + 8 * hiv), bf = *(const LAS bf16x8*)(XT + (32 * pb + r32v) * SS + ((16 * ks + 8 * hiv) ^ ((32 * pb + r32v) & 56)));
              yd = __builtin_amdgcn_mfma_f32_32x32x16_bf16(af, bf, yd, 0, 0, 0); } }
          const int p = 32 * pb + r32v;
#pragma unroll
          for (int r = 0; r < 16; ++r) { const int l = 32 * lb + crow(r, hiv); const float xs = bf2f(XT[p * SS + (l ^ (p & 56))]);
              YP[((T0 >> 7) * 16 + h) * 8192 + l * 64 + p] = (bf16_t)f2bf(yd[r] + dsk * xs);
              *state_ptr(ST, T0, h, 32 * nb + crow(r, hiv), p) = (bf16_t)f2bf(st[r]); } }
        LDS_BAR();
    }
}
__device__ __forceinline__ void ssd_scan(bf16_t* ST, const float* CD, int gtid, int nthreads) {
    for (int item = gtid; item < NB * 16 * 128 * 8; item += nthreads) {
        const int p8 = item & 7, n = (item >> 3) & 127, bh = item >> 10, b = bh >> 4, h = bh & 15;
        const float* cd = CD + bh * 32; float stt[8];
#pragma unroll
        for (int i = 0; i < 8; ++i) stt[i] = 0.f;
#pragma unroll 1
        for (int c0 = 0; c0 < 32; c0 += 16) { u32x4 v[16]; u32x4* ptr[16];
#pragma unroll
            for (int j = 0; j < 16; ++j) { ptr[j] = (u32x4*)state_ptr(ST, (size_t)b * SEQ + (size_t)(c0 + j) * 128, h, n, 8 * p8); v[j] = *ptr[j]; }
#pragma unroll
            for (int j = 0; j < 16; ++j) { u32x4 o; o.x = pk2(stt[0], stt[1]); o.y = pk2(stt[2], stt[3]); o.z = pk2(stt[4], stt[5]); o.w = pk2(stt[6], stt[7]); *ptr[j] = o;
                const float d = cd[c0 + j];
                stt[0] = stt[0] * d + bflo(v[j].x); stt[1] = stt[1] * d + bfhi(v[j].x); stt[2] = stt[2] * d + bflo(v[j].y); stt[3] = stt[3] * d + bfhi(v[j].y);
                stt[4] = stt[4] * d + bflo(v[j].z); stt[5] = stt[5] * d + bfhi(v[j].z); stt[6] = stt[6] * d + bflo(v[j].w); stt[7] = stt[7] * d + bfhi(v[j].w); } }
    }
}
constexpr int L2_CS = 0, L2_HT = 128 * SS * 2, L2_DT = L2_HT + 64 * SS * 2, L2_ACS = L2_DT + 4096;
__device__ __forceinline__ void ssdC_unit(int u, bf16_t* PROJ, bf16_t* ST, bf16_t* Zdst, int zpitch, int zcol, const bf16_t* YP, const float* DT, const float* convw, const float* convb, const float* dtb, const float* alog, LAS unsigned char* lds) {
    int tid = threadIdx.x; asm volatile("" : "+v"(tid)); const int lane = tid & 63, r32 = lane & 31, hi = lane >> 5; const int wid = __builtin_amdgcn_readfirstlane(tid >> 6);
    const int b = u >> 6, c = (u >> 1) & 31, g = u & 1;
    LAS bf16_t* Cs = (LAS bf16_t*)(lds + L2_CS); LAS bf16_t* HT = (LAS bf16_t*)(lds + L2_HT); LAS float* dtL8 = (LAS float*)(lds + L2_DT); LAS float* acsL8 = (LAS float*)(lds + L2_ACS);
    const size_t T0 = (size_t)b * SEQ + (size_t)c * 128;
    const int lb = wid >> 1, pb = wid & 1;
    const int hn = tid >> 3, hp8 = tid & 7;
    u32x4 hv[2];
#pragma unroll
    for (int j = 0; j < 2; ++j) hv[j] = *(const u32x4*)state_ptr(ST, T0, 8 * g, hn + 64 * j, 8 * hp8);
    { const int h = 8 * g + wid; dt_acs(DT, T0, h, dtb[h], -__expf(alog[h]), lane, dtL8 + wid * 128, acsL8 + wid * 128); }
    { ConvW W; const int v = tid & 15; const int ch = 1280 + g * 128 + v * 8; convw_load(W, ch, convw, convb); u32x4 raw[4][4];
#pragma unroll
      for (int j = 0; j < 4; ++j) { const int l = (tid >> 4) + 32 * j; conv_raw_load(raw[j], PROJ, T0 + l, c * 128 + l, ch); }
#pragma unroll
      for (int j = 0; j < 4; ++j) { const int l = (tid >> 4) + 32 * j; float o[8]; conv_compute(raw[j], W, o);
          u32x4 w; w.x = pk2(o[0], o[1]); w.y = pk2(o[2], o[3]); w.z = pk2(o[4], o[5]); w.w = pk2(o[6], o[7]); *(LAS u32x4*)(Cs + l * SS + v * 8) = w; } }
#pragma unroll 1
    for (int r8 = 0; r8 < 8; ++r8) {
        const int h = 8 * g + r8;
        int r32v = r32, hiv = hi; asm volatile("" : "+v"(r32v), "+v"(hiv));
        LAS float* acsL = acsL8 + r8 * 128;
#pragma unroll
        for (int j = 0; j < 2; ++j) { LAS bf16_t* d = HT + (8 * hp8) * SS + ((hn + 64 * j) ^ (8 * hp8)); const u32x4 w = hv[j];
            d[0] = (bf16_t)(w.x & 0xffff); d[SS] = (bf16_t)(w.x >> 16); d[2 * SS] = (bf16_t)(w.y & 0xffff); d[3 * SS] = (bf16_t)(w.y >> 16); d[4 * SS] = (bf16_t)(w.z & 0xffff); d[5 * SS] = (bf16_t)(w.z >> 16); d[6 * SS] = (bf16_t)(w.w & 0xffff); d[7 * SS] = (bf16_t)(w.w >> 16); }
        LDS_BAR();
        if (r8 < 7) {
#pragma unroll
            for (int j = 0; j < 2; ++j) hv[j] = *(const u32x4*)state_ptr(ST, T0, h + 1, hn + 64 * j, 8 * hp8); }
        { const int p = 32 * pb + r32v; unsigned short ypv[16], zv[16];
#pragma unroll
          for (int r = 0; r < 16; ++r) { const int l = 32 * lb + crow(r, hiv); ypv[r] = YP[((T0 >> 7) * 16 + h) * 8192 + l * 64 + p]; zv[r] = PROJ[(T0 + l) * LDP + PZ + h * 64 + p]; }
          f32x16 yo;
#pragma unroll
          for (int r = 0; r < 16; ++r) yo[r] = 0.f;
#pragma unroll
          for (int ks = 0; ks < 8; ++ks) { const bf16x8 af = *(const LAS bf16x8*)(Cs + (32 * lb + r32v) * SS + 16 * ks + 8 * hiv), bf = *(const LAS bf16x8*)(HT + (32 * pb + r32v) * SS + ((16 * ks + 8 * hiv) ^ ((32 * pb + r32v) & 56)));
              yo = __builtin_amdgcn_mfma_f32_32x32x16_bf16(af, bf, yo, 0, 0, 0); }
#pragma unroll
          for (int r = 0; r < 16; ++r) { const int l = 32 * lb + crow(r, hiv);
              const float y = bf2f(ypv[r]) + __expf(acsL[l]) * yo[r]; const float z = bf2f(zv[r]);
              Zdst[(T0 + l) * zpitch + zcol + h * 64 + p] = (bf16_t)f2bf(y * silu_f(z)); } }
        LDS_BAR();
    }
}

#define XB_TMO      128
#define XB_XCNT(j)  (256  + 64 * (j))
#define XB_XSUB(j)  (1280 + 64 * (j))
#define XB_XGEN(j)  (2304 + 64 * (j))
#define XB_TOP      3328
#define XB_TOPGEN   3392
#define XCD_BAR_WORDS 3456
#define XB_SPIN_CAP (1u << 18)
__device__ __forceinline__ unsigned xb_ld(unsigned* p)              { return __hip_atomic_load(p, __ATOMIC_RELAXED, __HIP_MEMORY_SCOPE_AGENT); }
__device__ __forceinline__ unsigned xb_add(unsigned* p, unsigned v) { return __hip_atomic_fetch_add(p, v, __ATOMIC_RELAXED, __HIP_MEMORY_SCOPE_AGENT); }
__device__ __forceinline__ unsigned xb_xcc_id() { return (unsigned)__builtin_amdgcn_s_getreg((3 << 11) | 20) & 0xFu; }
#define XB_SPIN(cond, bar) do { unsigned _sp = 0; while (cond) { __builtin_amdgcn_s_sleep(1); \
    if ((++_sp & 255u) == 0u) { if (xb_ld(&(bar)[XB_TMO])) break; if (_sp > XB_SPIN_CAP) { atomicAdd(&(bar)[XB_TMO], 1u); break; } } } } while (0)
struct XcdBarrier { unsigned* bar; unsigned x; volatile LAS unsigned* st; };
__device__ __forceinline__ XcdBarrier xcd_barrier_post(unsigned* bar, volatile LAS unsigned* st) {
    XcdBarrier b; b.bar = bar; b.x = xb_xcc_id(); b.st = st;
    if (threadIdx.x == 0) (void)xb_add(&bar[XB_XCNT(b.x)], 1u);
    return b;
}
__device__ __forceinline__ void xcd_barrier_complete(unsigned* bar, unsigned x, unsigned& nloc, unsigned& nx) {
    const unsigned G = gridDim.x * gridDim.y * gridDim.z;
    unsigned sum, cnt, mine, sp = 0u;
    for (;;) {
        sum = 0u; cnt = 0u; mine = 0u;
#pragma unroll
        for (unsigned j = 0; j < 16; ++j) { const unsigned c = xb_ld(&bar[XB_XCNT(j)]); sum += c; cnt += (c > 0u) ? 1u : 0u; mine = (j == x) ? c : mine; }
        if (sum == G) break;
        __builtin_amdgcn_s_sleep(1);
        if ((++sp & 255u) == 0u) { if (xb_ld(&bar[XB_TMO])) break; if (sp > XB_SPIN_CAP) { atomicAdd(&bar[XB_TMO], 1u); break; } }
    }
    nloc = mine > 0u ? mine : 1u; nx = cnt > 0u ? cnt : 1u;
}
__device__ __forceinline__ void xcd_barrier(const XcdBarrier& b) {
    asm volatile("s_waitcnt vmcnt(0)" ::: "memory");
    __syncthreads();
    if (threadIdx.x == 0) {
        unsigned* bar = b.bar;
        __builtin_amdgcn_s_waitcnt(0);
        unsigned nloc = b.st[0], nx = b.st[1];
        if (nloc == 0u) { xcd_barrier_complete(bar, b.x, nloc, nx); b.st[0] = nloc; b.st[1] = nx; }
        const unsigned old = xb_add(&bar[XB_XSUB(b.x)], 1u);
        const unsigned gen = old / nloc;
        if (old + 1u == (gen + 1u) * nloc) {
            __builtin_amdgcn_fence(__ATOMIC_RELEASE, "agent");
            asm volatile("s_waitcnt vmcnt(0)" ::: "memory");
            const unsigned og = xb_add(&bar[XB_TOP], 1u);
            const unsigned tg = og / nx;
            if (og + 1u == (tg + 1u) * nx) xb_add(&bar[XB_TOPGEN], 1u);
            else XB_SPIN(xb_ld(&bar[XB_TOPGEN]) == tg, bar);
            __builtin_amdgcn_fence(__ATOMIC_ACQUIRE, "agent");
            xb_add(&bar[XB_XGEN(b.x)], 1u);
            asm volatile("s_waitcnt vmcnt(0)" ::: "memory");
        } else {
            XB_SPIN(xb_ld(&bar[XB_XGEN(b.x)]) == gen, bar);
            __builtin_amdgcn_fence(__ATOMIC_ACQUIRE, "agent");
            asm volatile("s_waitcnt vmcnt(0)" ::: "memory");
        }
    }
    __syncthreads();
}

constexpr int LDS_BYTES = 147456; constexpr int SPARE_OFF = 131072;
__global__ void __launch_bounds__(512, 2) mega_fwd(Args args) {
    extern __shared__ __attribute__((aligned(16))) unsigned char lds_raw[];
    LAS unsigned char* lds = (LAS unsigned char*)lds_raw;
    cg::grid_group grid = cg::this_grid();
    const int tid = threadIdx.x, lane = tid & 63; const int wave = __builtin_amdgcn_readfirstlane(tid >> 6);
    const int G = gridDim.x, bid = blockIdx.x; const int gw = bid * NWAVES + wave, NGW = G * NWAVES;
    unsigned char* ws = args.ws;
    bf16_t* WGU1 = (bf16_t*)(ws + WS_WGU1); bf16_t* WD1 = (bf16_t*)(ws + WS_WD1); bf16_t* WIN = (bf16_t*)(ws + WS_WIN); bf16_t* WOUT = (bf16_t*)(ws + WS_WOUT);
    bf16_t* WQ = (bf16_t*)(ws + WS_WQ); bf16_t* WKV = (bf16_t*)(ws + WS_WKV); bf16_t* WO = (bf16_t*)(ws + WS_WO); bf16_t* WGU2 = (bf16_t*)(ws + WS_WGU2); bf16_t* WD2 = (bf16_t*)(ws + WS_WD2);
    bf16_t* MEMN = (bf16_t*)(ws + WS_MEMN); bf16_t* K2 = (bf16_t*)(ws + WS_K2); bf16_t* VT = (bf16_t*)(ws + WS_VT); float* DT = (float*)(ws + WS_DT);
    bf16_t* XN = (bf16_t*)(ws + WS_XN); bf16_t* BIG = (bf16_t*)(ws + WS_BIG);
    bf16_t* PROJ = BIG; bf16_t* ACT = BIG; bf16_t* Q2 = BIG; bf16_t* PB = BIG + (size_t)MTOK * DM;
    unsigned* ctl = (unsigned*)(ws + WS_CTL);
    const float* x = args.in[I_X]; float* H = args.out;
    bf16_t* HB = (bf16_t*)args.out;
    bf16_t* HB3 = (bf16_t*)(ws + WS_BIG + 200 * MiB);
    float* RS0 = (float*)(ws + WS_CTL + 131072);
    float* RSP1 = (float*)(ws + 74 * MiB); float* RSP2 = RSP1 + (size_t)MTOK * 4; float* RSP3 = RSP2 + (size_t)MTOK * 4;
    float* XB = (float*)(ws + WS_CTL + 1 * MiB);
    unsigned* XCNT = (unsigned*)(ws + WS_CTL + 32768);
    LAS float* XL = (LAS float*)(lds + SPARE_OFF);
    if (tid < 16) ((LAS unsigned*)(lds + LDS_BYTES - 64))[tid] = 0u;
    __syncthreads();
    const XcdBarrier xbar = xcd_barrier_post(ctl + 4096, (volatile LAS unsigned*)(lds + LDS_BYTES - 32));
#define GRID_BAR() xcd_barrier(xbar)

    {
        LAS float* scr = (LAS float*)(lds + wave * 16384);
        constexpr int I_GU = 16 * 176, I_D = 44 * 32, I_INP = 16 * 176, I_OUT = 32 * 32, I_Q = 16 * 32, I_KV = 16 * 64;
        constexpr int NITEMS = 2 * I_GU + 2 * I_D + I_INP + I_OUT + I_Q + I_KV;
        if ((wave & 1) == 0) {
        for (int it = gw; it < NITEMS; it += NGW) {
            int r = it;
            if (r < I_GU) { transpose_item(args.in[I_F1WGU], 1024, NGU, 176, WGU1, 1, scr, r, lane, args.in[I_F1PRE]); continue; } r -= I_GU;
            if (r < I_GU) { transpose_item(args.in[I_F2WGU], 1024, NGU, 176, WGU2, 1, scr, r, lane, args.in[I_F2PRE]); continue; } r -= I_GU;
            if (r < I_D) { transpose_item(args.in[I_F1WD], DFF, 1024, 32, WD1, 0, scr, r, lane); continue; } r -= I_D;
            if (r < I_D) { transpose_item(args.in[I_F2WD], DFF, 1024, 32, WD2, 0, scr, r, lane); continue; } r -= I_D;
            if (r < I_INP) { transpose_item(args.in[I_WIN], 1024, DIN_SRC, 176, WIN, 2, scr, r, lane, args.in[I_MIXPRE]); continue; } r -= I_INP;
            if (r < I_OUT) { transpose_item(args.in[I_WOUT], 2048, 1024, 32, WOUT, 0, scr, r, lane); continue; } r -= I_OUT;
            if (r < I_Q) { transpose_item(args.in[I_XAWO], 1024, 1024, 32, WO, 0, scr, r, lane); continue; } r -= I_Q;
            transpose_item(args.in[I_XAWKV], 1024, 2048, 64, WKV, 0, scr, r, lane);
        }
        } else {
        rms_rows_phase(x, args.in[I_F1PRE], XN, MTOK, gw, NGW, lane, RS0);
        rms_rows_phase(args.in[I_MEM], args.in[I_MEMG], MEMN, 2048, gw, NGW, lane);
        }
        for (int i = bid * 512 + tid; i < 1024 * 1024 / 8; i += G * 512) { const f32x4 a = ((const f32x4*)args.in[I_XAWQ])[2 * i], b2 = ((const f32x4*)args.in[I_XAWQ])[2 * i + 1];
            const float gk = args.in[I_XAPRE][i >> 7];
            u32x4 w; w.x = pk2(a.x * gk, a.y * gk); w.y = pk2(a.z * gk, a.w * gk); w.z = pk2(b2.x * gk, b2.y * gk); w.w = pk2(b2.z * gk, b2.w * gk); ((u32x4*)WQ)[i] = w; }
        for (int i = bid * 512 + tid; i < 256 * 1024; i += G * 512) { const int rr = i >> 10, k = i & 1023; const float v = (rr < 16) ? args.in[I_WIN][(size_t)k * DIN_SRC + 5632 + rr] * args.in[I_MIXPRE][k] : 0.f; WIN[(size_t)(5632 + rr) * 1024 + k] = (bf16_t)f2bf(v); }
        if ((wave & 1) == 0) {
        rms_rows_phase(x, args.in[I_F1PRE], XN, MTOK, gw, NGW, lane, RS0);
        rms_rows_phase(args.in[I_MEM], args.in[I_MEMG], MEMN, 2048, gw, NGW, lane);
        } else {
        for (int it = gw; it < NITEMS; it += NGW) {
            int r = it;
            if (r < I_GU) { transpose_item(args.in[I_F1WGU], 1024, NGU, 176, WGU1, 1, scr, r, lane, args.in[I_F1PRE]); continue; } r -= I_GU;
            if (r < I_GU) { transpose_item(args.in[I_F2WGU], 1024, NGU, 176, WGU2, 1, scr, r, lane, args.in[I_F2PRE]); continue; } r -= I_GU;
            if (r < I_D) { transpose_item(args.in[I_F1WD], DFF, 1024, 32, WD1, 0, scr, r, lane); continue; } r -= I_D;
            if (r < I_D) { transpose_item(args.in[I_F2WD], DFF, 1024, 32, WD2, 0, scr, r, lane); continue; } r -= I_D;
            if (r < I_INP) { transpose_item(args.in[I_WIN], 1024, DIN_SRC, 176, WIN, 2, scr, r, lane, args.in[I_MIXPRE]); continue; } r -= I_INP;
            if (r < I_OUT) { transpose_item(args.in[I_WOUT], 2048, 1024, 32, WOUT, 0, scr, r, lane); continue; } r -= I_OUT;
            if (r < I_Q) { transpose_item(args.in[I_XAWO], 1024, 1024, 32, WO, 0, scr, r, lane); continue; } r -= I_Q;
            transpose_item(args.in[I_XAWKV], 1024, 2048, 64, WKV, 0, scr, r, lane);
        }
        }
    }
    grid.sync();
    { pg8::Sched S = pg8::make_sched(XN, 1024, WGU1, 1024, MTOK, NGU, 1024, G, bid); pg8::EpiSwiglu E{ACT, DFF, RS0, false}; pg8::gemm_phase<pg8::EpiSwiglu, true>(lds, S, E); }
    GRID_BAR();
    { pg8::Sched S = pg8::make_sched(ACT, DFF, WD1, DFF, MTOK, 1024, DFF, G, bid);
      pg8::EpiResX<false> E{XN, HB, args.in[I_F1POST], 0.5f, RSP1, XB, XCNT + 0 * 128 * 16, XL}; pg8::gemm_phase<pg8::EpiResX<false>, true>(lds, S, E); }
    GRID_BAR();
    { pg8::Sched S = pg8::make_sched(HB, 1024, WIN, 1024, MTOK, NIN, 1024, G, bid); pg8::EpiInProj E{PROJ, DT, RSP1, true}; pg8::gemm_phase<pg8::EpiInProj, true>(lds, S, E); }
    { const int c2 = (G >= 256) ? bid - 128 : bid;
      pg8::Sched S = pg8::make_sched(MEMN, 1024, WKV, 1024, 2048, 2048, 1024, (G >= 256) ? 64 : G, (G >= 256) ? ((c2 >= 0 && c2 < 64) ? c2 : -1) : bid); pg8::EpiStore E{K2, 2048}; pg8::gemm_phase<pg8::EpiStore, true>(lds, S, E); }
    GRID_BAR();
    bf16_t* WQK = (bf16_t*)(ws + WS_WQK);
    { pg8::Sched S = pg8::make_sched(K2, 2048, WQ, 1024, 256, 1024, 256, G, bid); S.nBt = 32; S.nH = 4;
      S.sAb = (long)256 * 2048 * 2; S.sAh = 256 * 2; S.sBb = 0; S.sBh = 256 * 2; S.sOb = (long)1024 * 1024; S.sOh = (long)256 * 1024;
      pg8::EpiStore E{WQK, 1024}; pg8::gemm_phase<pg8::EpiStore, true>(lds, S, E); }
    attn_phase(PROJ, PROJ, LDP, PQ, lds, bid, G);
    __syncthreads();
    float* CD = (float*)(ws + WS_CTL + 65536);
    bf16_t* ST = (bf16_t*)args.out + (size_t)MTOK * DM;
    for (int u = bid; u < 512; u += G) ssdA_unit(u, PROJ, ST, XN, CD, DT, args.in[I_CONVW], args.in[I_CONVB], args.in[I_DTB], args.in[I_ALOG], args.in[I_DSKIP], lds);
    GRID_BAR();
    ssd_scan(ST, CD, bid * 512 + opaque_tid(), G * 512);
    GRID_BAR();
    for (int u = bid; u < 512; u += G) ssdC_unit(u, PROJ, ST, PROJ, LDP, PZ, XN, DT, args.in[I_CONVW], args.in[I_CONVB], args.in[I_DTB], args.in[I_ALOG], lds);
    GRID_BAR();
    { const int ot = opaque_tid(); mixnorm_phase(PROJ, args.in[I_ATTG], args.in[I_SSDG], bid * NWAVES + __builtin_amdgcn_readfirstlane(ot >> 6), NGW, ot & 63); }
    GRID_BAR();
    { pg8::Sched S = pg8::make_sched(PROJ, LDP, WOUT, 2048, MTOK, 1024, 2048, G, bid);
      pg8::EpiResX<false> E{HB, HB, args.in[I_MIXPOST], 1.0f, RSP2, XB, XCNT + 1 * 128 * 16, XL}; pg8::gemm_phase<pg8::EpiResX<false>, true>(lds, S, E); }
    GRID_BAR();
    bf16_t* VW = BIG;
    { pg8::Sched S = pg8::make_sched(WO, 1024, K2 + 1024, 2048, 1024, 256, 256, G, bid); S.nBt = 32; S.nH = 4;
      S.sAb = 0; S.sAh = 256 * 2; S.sBb = (long)256 * 2048 * 2; S.sBh = 256 * 2; S.sOb = (long)1024 * 1024; S.sOh = 256;
      pg8::EpiStore E{VW, 1024}; pg8::gemm_phase<pg8::EpiStore, true>(lds, S, E); }
    { pg8::Sched S = pg8::make_sched(HB, 1024, WQK, 1024, SEQ, 1024, 1024, G, bid); S.nBt = 8; S.nH = 1; S.sRb = SEQ;
      S.sAb = (long)SEQ * 1024 * 2; S.sAh = 0; S.sBb = (long)1024 * 1024 * 2; S.sBh = 0; S.sOb = (long)SEQ * 1024; S.sOh = 0;
      pg8::EpiSoftmax E{PB, 1024, 0.0625f, (LAS float*)(lds + SPARE_OFF), RSP2}; pg8::gemm_phase<pg8::EpiSoftmax, true>(lds, S, E); }
    GRID_BAR();
    { pg8::Sched S = pg8::make_sched(PB, 1024, VW, 1024, SEQ, 1024, 1024, G, bid); S.nBt = 8; S.nH = 1; S.sRb = SEQ;
      S.sAb = (long)SEQ * 1024 * 2; S.sAh = 0; S.sBb = (long)1024 * 1024 * 2; S.sBh = 0; S.sOb = (long)SEQ * 1024; S.sOh = 0;
      pg8::EpiResX<false> E{HB, HB3, args.in[I_XAPOST], 1.0f, RSP3, XB, XCNT + 2 * 128 * 16, XL}; pg8::gemm_phase<pg8::EpiResX<false>, true>(lds, S, E); }
    GRID_BAR();
    { pg8::Sched S = pg8::make_sched(HB3, 1024, WGU2, 1024, MTOK, NGU, 1024, G, bid); pg8::EpiSwiglu E{ACT, DFF, RSP3, true}; pg8::gemm_phase<pg8::EpiSwiglu, true>(lds, S, E); }
    GRID_BAR();
    { pg8::Sched S = pg8::make_sched(ACT, DFF, WD2, DFF, MTOK, 1024, DFF, G, bid);
      pg8::EpiResX<true> E{HB3, H, args.in[I_F2POST], 0.5f, nullptr, XB, XCNT + 3 * 128 * 16, XL}; pg8::gemm_phase<pg8::EpiResX<true>, true>(lds, S, E); }
}

extern "C" void kernel_launch(void* const* d_in, const int* in_sizes, int n_in, void* d_out, int out_size, void* d_ws, size_t ws_size, hipStream_t stream) {
    static int grid = 0;
    if (grid == 0) {
        if (n_in != 27 || out_size != MTOK * DM || ws_size < WS_END) { fprintf(stderr, "kernel_launch: unexpected sizes n_in %d out %d ws %zu\n", n_in, out_size, ws_size); grid = -1; return; }
        int dev = 0, cus = 0, per_cu = 0;
        hipGetDevice(&dev); hipDeviceGetAttribute(&cus, hipDeviceAttributeMultiprocessorCount, dev);
        if (hipFuncSetAttribute((const void*)mega_fwd, hipFuncAttributeMaxDynamicSharedMemorySize, LDS_BYTES) != hipSuccess) { fprintf(stderr, "kernel_launch: hipFuncSetAttribute failed\n"); grid = -1; return; }
        if (hipOccupancyMaxActiveBlocksPerMultiprocessor(&per_cu, (const void*)mega_fwd, 512, LDS_BYTES) != hipSuccess || per_cu < 1) { fprintf(stderr, "kernel_launch: occupancy query says %d\n", per_cu); per_cu = 1; }
        (void)hipGetLastError();
        grid = cus;
        if (grid < 128) { fprintf(stderr, "kernel_launch: needs >= 128 CUs\n"); }
    }
    if (grid < 0) return;
    (void)hipMemsetAsync((char*)d_ws + WS_CTL, 0, 65536, stream);
    Args a{};
    for (int i = 0; i < 27; ++i) a.in[i] = (const float*)d_in[i];
    a.out = (float*)d_out; a.ws = (unsigned char*)d_ws;
    void* kargs[] = {&a};
    hipError_t e = hipLaunchCooperativeKernel((const void*)mega_fwd, dim3(grid), dim3(512), kargs, LDS_BYTES, stream);
    if (e != hipSuccess) fprintf(stderr, "cooperative launch failed: %s (grid %d)\n", hipGetErrorString(e), grid);
}
```

```cpp
#include <hip/hip_runtime.h>
#include <hip/hip_cooperative_groups.h>
#include <cstdio>
#include <cstdint>
namespace cg = cooperative_groups;

#define LAS __attribute__((address_space(3)))
typedef unsigned short bf16_t;
typedef short bf16x8 __attribute__((ext_vector_type(8)));
typedef short bf16x4 __attribute__((ext_vector_type(4)));
typedef float f32x4 __attribute__((ext_vector_type(4)));
typedef float f32x16 __attribute__((ext_vector_type(16)));
typedef unsigned u32x4 __attribute__((ext_vector_type(4)));
typedef unsigned u32x2 __attribute__((ext_vector_type(2)));

constexpr int MTOK = 32768, DM = 1024, SEQ = 4096, NB = 8;
constexpr int DFF = 2816, NGU = 5632;
constexpr int LDP = 5632;
constexpr int NIN = 5888;
constexpr int DIN_SRC = 5648;
constexpr int PQ = 0, PZ = 1024, PK = 2048, PV = 3072, PX = 4096;
constexpr float EPS = 1e-6f;
constexpr int NWAVES = 8;

constexpr size_t MiB = 1u << 20;
constexpr size_t WS_CTL = 0;
constexpr size_t WS_WGU1 = 2 * MiB, WS_WD1 = 13 * MiB, WS_WIN = 19 * MiB, WS_WOUT = 31 * MiB, WS_WQ = 35 * MiB, WS_WKV = 37 * MiB, WS_WO = 41 * MiB;
constexpr size_t WS_WGU2 = 43 * MiB, WS_WD2 = 54 * MiB, WS_MEMN = 60 * MiB, WS_K2 = 64 * MiB, WS_VT = 68 * MiB, WS_DT = 72 * MiB;
constexpr size_t WS_XN = 76 * MiB;
constexpr size_t WS_BIG = 140 * MiB;
constexpr size_t WS_WQK = 492 * MiB;
constexpr size_t WS_END = 508 * MiB;

typedef float f32x2_t __attribute__((ext_vector_type(2))); typedef __bf16 bf16x2_t __attribute__((ext_vector_type(2)));
__device__ __forceinline__ unsigned pk2(float lo, float hi) { const f32x2_t v = {lo, hi}; const bf16x2_t b = __builtin_convertvector(v, bf16x2_t); return __builtin_bit_cast(unsigned, b); }
__device__ __forceinline__ unsigned f2bf(float f) { return pk2(f, f) & 0xffffu; }
__device__ __forceinline__ float bf2f(unsigned short b) { return __builtin_bit_cast(float, (unsigned)b << 16); }
__device__ __forceinline__ float bflo(unsigned w) { return __builtin_bit_cast(float, w << 16); }
__device__ __forceinline__ float bfhi(unsigned w) { return __builtin_bit_cast(float, w & 0xffff0000u); }
__device__ __forceinline__ float wave_sum(float v) {
#pragma unroll
    for (int o = 1; o < 64; o <<= 1) v += __shfl_xor(v, o);
    return v;
}
__device__ __forceinline__ float silu_f(float v) { return v * __builtin_amdgcn_rcpf(1.f + __expf(-v)); }
__device__ __forceinline__ float softplus_f(float z) { return fmaxf(z, 0.f) + __logf(1.f + __expf(-fabsf(z))); }
__device__ __forceinline__ int crow(int r, int hi) { return (r & 3) + 8 * (r >> 2) + 4 * hi; }

namespace pg8 {
constexpr int BM = 256, BK = 64, HALF = 128, HTB = HALF * BK * 2, STAGE_BYTES = 8 * HTB, NXCD = 8, WGM = 8;
__device__ __forceinline__ int lds_byte(int r, int c) { const int st = (r >> 4) * 2 + (c >> 5), rr = r & 15, cc = c & 31, ob = rr * 64 + cc * 2; return st * 1024 + (ob ^ (((ob >> 9) & 1) << 5)); }
__device__ __forceinline__ void stage_rc(int b, int& R, int& C) { const int st = b / 1024, sb = b % 1024, swz = sb ^ (((sb >> 9) & 1) << 5); R = (st >> 1) * 16 + swz / 64; C = (st & 1) * 32 + (swz % 64) / 2; }
__device__ __forceinline__ int perm32(int rho) { const int n = rho >> 4, i = rho & 15; return 8 * (i >> 2) + 4 * n + (i & 3); }

struct Unit { int pm, pn, bt; const char* a; const char* b; long o; int r; };
struct Sched {
    const char* A; const char* B; int lda, ldb, K;
    int nM, nN, nBt, nH; long sAb, sAh, sBb, sBh, sOb, sOh; int sRb; int G, c;
    __device__ __forceinline__ bool next(int i, Unit& u) const {
        if (c < 0) return false;
        const int per = nM * nN; const long nwgl = (long)per * nBt; const long L = (long)i * G + c; if (L >= nwgl) return false;
        int bt = (int)(L / per); int wgid = (int)(L % per);
        if (nBt == 1) {
            const int nwg = per; const int q = nwg / NXCD, r = nwg % NXCD, xcd = wgid % NXCD, off = wgid / NXCD; wgid = (xcd < r ? xcd * (q + 1) : r * (q + 1) + (xcd - r) * q) + off;
            const int nig = WGM * nN, gid = wgid / nig, fm = gid * WGM, gsz = (nM - fm) < WGM ? (nM - fm) : WGM;
            u.pm = fm + ((wgid % nig) % gsz); u.pn = (wgid % nig) / gsz;
        } else if (nBt == 8 && nM == 16 && nN == 4 && G == 256) {
            const int slot = i * 8 + (c & 7), j = c >> 3; bt = slot >> 1; u.pm = (slot & 1) * 8 + (j & 7); u.pn = j >> 3;
        } else { u.pm = wgid % nM; u.pn = wgid / nM; }
        u.bt = bt; const int bb = bt / nH, hh = bt % nH;
        u.a = A + bb * sAb + hh * sAh + (size_t)u.pm * BM * lda * 2;
        u.b = B + bb * sBb + hh * sBh + (size_t)u.pn * BM * ldb * 2;
        u.o = bb * sOb + hh * sOh; u.r = bb * sRb;
        return true;
    }
};
__device__ __forceinline__ Sched make_sched(const void* A, int lda, const void* B, int ldb, int M, int N, int K, int G, int c) {
    Sched s; s.A = (const char*)A; s.B = (const char*)B; s.lda = lda; s.ldb = ldb; s.K = K; s.nM = M / BM; s.nN = N / BM; s.nBt = 1; s.nH = 1;
    s.sAb = s.sAh = s.sBb = s.sBh = s.sOb = s.sOh = 0; s.sRb = 0; s.G = G; s.c = c; return s;
}

__device__ __forceinline__ unsigned cvt_pk_bf16(float lo, float hi) { unsigned r; asm volatile("v_cvt_pk_bf16_f32 %0, %1, %2" : "=v"(r) : "v"(lo), "v"(hi)); return r; }

__device__ __forceinline__ float row_scale(const float* rs, int row, bool part) {
    if (!part) return rs[row];
    const f32x4 p = *(const f32x4*)(rs + (size_t)row * 4); return rsqrtf(((p.x + p.y) + (p.z + p.w)) * (1.f / 1024.f) + 1e-6f);
}
struct EpiStore {
    bf16_t* O; int ldc;
    __device__ __forceinline__ void operator()(const f32x4 (&acc)[2][2][4][2], const Unit& u, int wr, int wc, int fr, int fq) const {
        const int row0 = u.pm * BM + wr * 64 + fr; const int col0 = u.pn * BM + wc * 32 + 8 * fq; bf16_t* base = O + u.o;
#pragma unroll
        for (int ai = 0; ai < 2; ++ai)
#pragma unroll
            for (int m = 0; m < 4; ++m) { bf16_t* rowp = base + (size_t)(row0 + ai * HALF + m * 16) * ldc + col0;
#pragma unroll
                for (int bj = 0; bj < 2; ++bj) { const f32x4 v0 = acc[ai][bj][m][0], v1 = acc[ai][bj][m][1];
                    u32x4 w; w.x = cvt_pk_bf16(v0[0], v0[1]); w.y = cvt_pk_bf16(v0[2], v0[3]); w.z = cvt_pk_bf16(v1[0], v1[1]); w.w = cvt_pk_bf16(v1[2], v1[3]);
                    *(u32x4*)(rowp + bj * HALF) = w; } }
    }
};
struct EpiSwiglu {
    bf16_t* O; int ldc; const float* rs; bool part;
    __device__ __forceinline__ void operator()(const f32x4 (&acc)[2][2][4][2], const Unit& u, int wr, int wc, int fr, int fq) const {
        const int row0 = u.pm * BM + wr * 64 + fr; const int col0 = u.pn * HALF + wc * 32 + 8 * fq;
#pragma unroll
        for (int ai = 0; ai < 2; ++ai)
#pragma unroll
            for (int m = 0; m < 4; ++m) { bf16_t* rowp = O + (size_t)(row0 + ai * HALF + m * 16) * ldc + col0; const float sc = row_scale(rs, row0 + ai * HALF + m * 16, part);
                float r[8];
#pragma unroll
                for (int n = 0; n < 2; ++n)
#pragma unroll
                    for (int j = 0; j < 4; ++j) { const float g = acc[ai][0][m][n][j] * sc, uu = acc[ai][1][m][n][j] * sc; r[4 * n + j] = g * __builtin_amdgcn_rcpf(1.f + __expf(-g)) * uu; }
                u32x4 w; w.x = cvt_pk_bf16(r[0], r[1]); w.y = cvt_pk_bf16(r[2], r[3]); w.z = cvt_pk_bf16(r[4], r[5]); w.w = cvt_pk_bf16(r[6], r[7]);
                *(u32x4*)rowp = w; }
    }
};
struct EpiInProj {
    bf16_t* O; float* DT; const float* rs; bool part;
    __device__ __forceinline__ void operator()(const f32x4 (&acc)[2][2][4][2], const Unit& u, int wr, int wc, int fr, int fq) const {
        const int row0 = u.pm * BM + wr * 64 + fr;
        if (u.pn < 22) {
            const int col0 = u.pn * BM + wc * 32 + 8 * fq;
#pragma unroll
            for (int ai = 0; ai < 2; ++ai)
#pragma unroll
                for (int m = 0; m < 4; ++m) { bf16_t* rowp = O + (size_t)(row0 + ai * HALF + m * 16) * LDP + col0; const float sc = row_scale(rs, row0 + ai * HALF + m * 16, part);
#pragma unroll
                    for (int bj = 0; bj < 2; ++bj) { const f32x4 v0 = acc[ai][bj][m][0] * sc, v1 = acc[ai][bj][m][1] * sc;
                        u32x4 w; w.x = cvt_pk_bf16(v0[0], v0[1]); w.y = cvt_pk_bf16(v0[2], v0[3]); w.z = cvt_pk_bf16(v1[0], v1[1]); w.w = cvt_pk_bf16(v1[2], v1[3]);
                        *(u32x4*)(rowp + bj * HALF) = w; } }
        } else if (wc == 0 && fq < 2) {
#pragma unroll
            for (int ai = 0; ai < 2; ++ai)
#pragma unroll
                for (int m = 0; m < 4; ++m) { float* rowp = DT + (size_t)(row0 + ai * HALF + m * 16) * 16 + 8 * fq; const float sc = row_scale(rs, row0 + ai * HALF + m * 16, part);
                    *(f32x4*)rowp = acc[ai][0][m][0] * sc; *(f32x4*)(rowp + 4) = acc[ai][0][m][1] * sc; }
        }
    }
};
struct EpiSoftmax {
    bf16_t* O; int ldc; float scale; LAS float* X; const float* rs;
    __device__ __forceinline__ void operator()(f32x4 (&acc)[2][2][4][2], const Unit& u, int wr, int wc, int fr, int fq) const {
        float mx[2][4];
#pragma unroll
        for (int ai = 0; ai < 2; ++ai)
#pragma unroll
            for (int m = 0; m < 4; ++m) { float a = -3.0e38f;
#pragma unroll
                for (int bj = 0; bj < 2; ++bj)
#pragma unroll
                    for (int n = 0; n < 2; ++n)
#pragma unroll
                        for (int j = 0; j < 4; ++j) a = fmaxf(a, acc[ai][bj][m][n][j]);
                a = fmaxf(a, __shfl_xor(a, 16)); a = fmaxf(a, __shfl_xor(a, 32));
                if (fq == 0) X[(ai * HALF + wr * 64 + m * 16 + fr) * 4 + wc] = a; }
        asm volatile("s_waitcnt lgkmcnt(0)" ::: "memory"); __builtin_amdgcn_s_barrier(); asm volatile("" ::: "memory");
#pragma unroll
        for (int ai = 0; ai < 2; ++ai)
#pragma unroll
            for (int m = 0; m < 4; ++m) { const f32x4 t = *(const LAS f32x4*)(X + (ai * HALF + wr * 64 + m * 16 + fr) * 4);
                const float rm = fmaxf(fmaxf(t[0], t[1]), fmaxf(t[2], t[3])); float s = 0.f; const float scl = scale * row_scale(rs, u.r + u.pm * BM + ai * HALF + wr * 64 + m * 16 + fr, true);
#pragma unroll
                for (int bj = 0; bj < 2; ++bj)
#pragma unroll
                    for (int n = 0; n < 2; ++n)
#pragma unroll
                        for (int j = 0; j < 4; ++j) { const float e = __expf((acc[ai][bj][m][n][j] - rm) * scl); acc[ai][bj][m][n][j] = e; s += e; }
                s += __shfl_xor(s, 16); s += __shfl_xor(s, 32);
                if (fq == 0) X[1024 + (ai * HALF + wr * 64 + m * 16 + fr) * 4 + wc] = s; mx[ai][m] = 0.f; }
        asm volatile("s_waitcnt lgkmcnt(0)" ::: "memory"); __builtin_amdgcn_s_barrier(); asm volatile("" ::: "memory");
        const int row0 = u.pm * BM + wr * 64 + fr; const int col0 = u.pn * BM + wc * 32 + 8 * fq; bf16_t* base = O + u.o;
#pragma unroll
        for (int ai = 0; ai < 2; ++ai)
#pragma unroll
            for (int m = 0; m < 4; ++m) { const f32x4 t = *(const LAS f32x4*)(X + 1024 + (ai * HALF + wr * 64 + m * 16 + fr) * 4);
                const float inv = 1.f / ((t[0] + t[1]) + (t[2] + t[3])); bf16_t* rowp = base + (size_t)(row0 + ai * HALF + m * 16) * ldc + col0;
#pragma unroll
                for (int bj = 0; bj < 2; ++bj) { const f32x4 v0 = acc[ai][bj][m][0] * inv, v1 = acc[ai][bj][m][1] * inv;
                    u32x4 w; w.x = cvt_pk_bf16(v0[0], v0[1]); w.y = cvt_pk_bf16(v0[2], v0[3]); w.z = cvt_pk_bf16(v1[0], v1[1]); w.w = cvt_pk_bf16(v1[2], v1[3]);
                    *(u32x4*)(rowp + bj * HALF) = w; } }
        (void)mx;
    }
};

template <bool OUT_F32>
struct EpiResX {
    const bf16_t* hin; void* hout; const float* gpost; float scale; float* rsp; float* xb; unsigned* cnt; LAS float* X;
    __device__ __forceinline__ void operator()(const f32x4 (&acc)[2][2][4][2], const Unit& u, int wr, int wc, int fr, int fq) const {
        int t_ = threadIdx.x; asm volatile("" : "+v"(t_)); const int lane = t_ & 63; const int wid = __builtin_amdgcn_readfirstlane(t_ >> 6);
        LAS float* P = X; LAS float* Sx = X + 1024;
        const int grow0 = u.r + u.pm * BM; const int panel = grow0 >> 8; const int col0 = u.pn * BM + wc * 32 + 8 * fq;
        u32x4 hv[4][2];
#pragma unroll
        for (int m = 0; m < 4; ++m)
#pragma unroll
            for (int bj = 0; bj < 2; ++bj) hv[m][bj] = __builtin_nontemporal_load((const u32x4*)(hin + (size_t)(grow0 + wr * 64 + m * 16 + fr) * 1024 + col0 + bj * HALF));
#pragma unroll
        for (int ai = 0; ai < 2; ++ai)
#pragma unroll
            for (int m = 0; m < 4; ++m) { float q = 0.f;
#pragma unroll
                for (int bj = 0; bj < 2; ++bj)
#pragma unroll
                    for (int n = 0; n < 2; ++n) { const f32x4 v = acc[ai][bj][m][n]; q += (v[0] * v[0] + v[1] * v[1]) + (v[2] * v[2] + v[3] * v[3]); }
                q += __shfl_xor(q, 16); q += __shfl_xor(q, 32);
                if (fq == 0) P[(ai * HALF + wr * 64 + m * 16 + fr) * 4 + wc] = q; }
        asm volatile("s_waitcnt lgkmcnt(0)" ::: "memory"); __builtin_amdgcn_s_barrier(); asm volatile("" ::: "memory");
        const int row = wid * 32 + (lane & 31);
        if (lane < 32) { const f32x4 t = *(const LAS f32x4*)(P + row * 4);
            __hip_atomic_store(xb + (size_t)(grow0 + row) * 4 + u.pn, (t[0] + t[1]) + (t[2] + t[3]), __ATOMIC_RELAXED, __HIP_MEMORY_SCOPE_AGENT); }
        asm volatile("s_waitcnt vmcnt(0)" ::: "memory");
        if (lane == 0) __hip_atomic_fetch_add(cnt + 16 * panel, 1u, __ATOMIC_RELAXED, __HIP_MEMORY_SCOPE_AGENT);
        if (wid == 0) { unsigned sp = 0u;
            while ((unsigned)__builtin_amdgcn_readfirstlane(__hip_atomic_load(cnt + 16 * panel, __ATOMIC_RELAXED, __HIP_MEMORY_SCOPE_AGENT)) < 32u) { __builtin_amdgcn_s_sleep(2); if (++sp > (1u << 22)) break; }
            __builtin_amdgcn_fence(__ATOMIC_ACQUIRE, "agent"); }
        asm volatile("s_waitcnt vmcnt(0) lgkmcnt(0)" ::: "memory"); __builtin_amdgcn_s_barrier(); asm volatile("" ::: "memory");
        if (lane < 32) { const float* sl = xb + (size_t)(grow0 + row) * 4; float q = 0.f;
#pragma unroll
            for (int t = 0; t < 4; ++t) q += __hip_atomic_load(sl + t, __ATOMIC_RELAXED, __HIP_MEMORY_SCOPE_AGENT);
            Sx[row] = rsqrtf(q * (1.f / 1024.f) + 1e-6f) * scale; }
        asm volatile("s_waitcnt vmcnt(0) lgkmcnt(0)" ::: "memory"); __builtin_amdgcn_s_barrier(); asm volatile("" ::: "memory");
        f32x4 gg[2][2];
#pragma unroll
        for (int bj = 0; bj < 2; ++bj) { gg[bj][0] = *(const f32x4*)(gpost + col0 + bj * HALF); gg[bj][1] = *(const f32x4*)(gpost + col0 + bj * HALF + 4); }
#pragma unroll
        for (int ai = 0; ai < 2; ++ai) {
            if (ai == 1) {
#pragma unroll
                for (int m = 0; m < 4; ++m)
#pragma unroll
                    for (int bj = 0; bj < 2; ++bj) hv[m][bj] = __builtin_nontemporal_load((const u32x4*)(hin + (size_t)(grow0 + HALF + wr * 64 + m * 16 + fr) * 1024 + col0 + bj * HALF)); }
#pragma unroll
            for (int m = 0; m < 4; ++m) { const int rl = ai * HALF + wr * 64 + m * 16 + fr; const float rsf = Sx[rl]; float q = 0.f;
#pragma unroll
                for (int bj = 0; bj < 2; ++bj) { const u32x4 hw = hv[m][bj];
                    const f32x4 h0 = (f32x4){bflo(hw.x), bfhi(hw.x), bflo(hw.y), bfhi(hw.y)} + acc[ai][bj][m][0] * rsf * gg[bj][0];
                    const f32x4 h1 = (f32x4){bflo(hw.z), bfhi(hw.z), bflo(hw.w), bfhi(hw.w)} + acc[ai][bj][m][1] * rsf * gg[bj][1];
                    q += ((h0[0] * h0[0] + h0[1] * h0[1]) + (h0[2] * h0[2] + h0[3] * h0[3])) + ((h1[0] * h1[0] + h1[1] * h1[1]) + (h1[2] * h1[2] + h1[3] * h1[3]));
                    const size_t off = (size_t)(grow0 + rl) * 1024 + col0 + bj * HALF;
                    if (OUT_F32) { __builtin_nontemporal_store(h0, (f32x4*)((float*)hout + off)); __builtin_nontemporal_store(h1, (f32x4*)((float*)hout + off + 4)); }
                    else { u32x4 w; w.x = cvt_pk_bf16(h0[0], h0[1]); w.y = cvt_pk_bf16(h0[2], h0[3]); w.z = cvt_pk_bf16(h1[0], h1[1]); w.w = cvt_pk_bf16(h1[2], h1[3]); *(u32x4*)((bf16_t*)hout + off) = w; } }
                q += __shfl_xor(q, 16); q += __shfl_xor(q, 32);
                if (fq == 0) P[rl * 4 + wc] = q; } }
        asm volatile("s_waitcnt lgkmcnt(0)" ::: "memory"); __builtin_amdgcn_s_barrier(); asm volatile("" ::: "memory");
        if (rsp && lane < 32) { const f32x4 t = *(const LAS f32x4*)(P + row * 4); rsp[(size_t)(grow0 + row) * 4 + u.pn] = (t[0] + t[1]) + (t[2] + t[3]); }
    }
};

template <class Epi, bool ALIGN_EPI>
__device__ __forceinline__ void gemm_phase(LAS unsigned char* lds, const Sched& S, Epi& E) {
    int tid = threadIdx.x; asm volatile("" : "+v"(tid));
    const int wid = __builtin_amdgcn_readfirstlane(tid >> 6), lane = tid & 63, wr = wid >> 2, wc = wid & 3, fr = lane & 15, fq = lane >> 4;
    const int K = S.K, nt = K / BK;
    unsigned voffA[2], voffB[2];
#pragma unroll
    for (int i = 0; i < 2; ++i) { int R, C; stage_rc(tid * 16 + i * 8192, R, C); const int Rb = (R & ~31) + perm32(R & 31);
        voffA[i] = (unsigned)(R * S.lda + C) * 2u; voffB[i] = (unsigned)(Rb * S.ldb + C) * 2u; }
    const size_t kstep = (size_t)(BK * 2);
    const size_t hA = (size_t)HALF * S.lda * 2, hB = (size_t)HALF * S.ldb * 2;
    const unsigned ldsw = (unsigned)wid * 1024u;
    const int aoff = lds_byte(wr * 64 + fr, fq * 8), boff = lds_byte(wc * 32 + fr, fq * 8);
#define PG8_SA(b, h) (((b) * 2 + (h)) * HTB)
#define PG8_SB(b, h) ((4 + (b) * 2 + (h)) * HTB)
#define PG8_STAGE(bufoff, gbase, voff) do { _Pragma("unroll") for (int _i = 0; _i < 2; ++_i) \
        __builtin_amdgcn_global_load_lds((const unsigned*)((const char*)(gbase) + (voff)[_i]), (LAS unsigned*)(lds + (bufoff) + ldsw + _i * 8192), 16, 0, 0); } while (0)
#define PG8_LDA(dst, b, h) do { _Pragma("unroll") for (int m = 0; m < 4; ++m) _Pragma("unroll") for (int k = 0; k < 2; ++k) dst[m][k] = *(const LAS bf16x8*)(lds + PG8_SA(b, h) + aoff + m * 2048 + k * 1024); } while (0)
#define PG8_LDB(dst, b, h) do { _Pragma("unroll") for (int n = 0; n < 2; ++n) _Pragma("unroll") for (int k = 0; k < 2; ++k) dst[n][k] = *(const LAS bf16x8*)(lds + PG8_SB(b, h) + boff + n * 2048 + k * 1024); } while (0)
#define PG8_MMA(ai, bj, At, Bt) do { __builtin_amdgcn_s_setprio(1); _Pragma("unroll") for (int m = 0; m < 4; ++m) _Pragma("unroll") for (int n = 0; n < 2; ++n) _Pragma("unroll") for (int k = 0; k < 2; ++k) \
        acc[ai][bj][m][n] = __builtin_amdgcn_mfma_f32_16x16x32_bf16(Bt[n][k], At[m][k], acc[ai][bj][m][n], 0, 0, 0); __builtin_amdgcn_s_setprio(0); } while (0)
#define PG8_WAIT_V(n) asm volatile("s_waitcnt vmcnt(" #n ")" ::: "memory")
#define PG8_WAIT_L(n) asm volatile("s_waitcnt lgkmcnt(" #n ")" ::: "memory")
#define PG8_BAR __builtin_amdgcn_s_barrier()
#define PG8_SCHED __builtin_amdgcn_sched_barrier(0)
    Unit cur, nxt; int ui = 0;
    if (!S.next(0, cur)) return;
    f32x4 acc[2][2][4][2];
#pragma unroll
    for (int a = 0; a < 2; ++a)
#pragma unroll
        for (int b = 0; b < 2; ++b)
#pragma unroll
            for (int m = 0; m < 4; ++m)
#pragma unroll
                for (int n = 0; n < 2; ++n) acc[a][b][m][n] = (f32x4){0.f, 0.f, 0.f, 0.f};
    bf16x8 At[4][2], B0[2][2], B1[2][2];
    const char* cA = cur.a; const char* cB = cur.b;
    PG8_STAGE(PG8_SB(0, 0), cB, voffB); PG8_STAGE(PG8_SB(0, 1), cB + hB, voffB); PG8_STAGE(PG8_SA(0, 0), cA, voffA); PG8_STAGE(PG8_SA(0, 1), cA + hA, voffA);
    if (wr == 1) PG8_BAR;
    PG8_WAIT_V(2); PG8_BAR;
    PG8_STAGE(PG8_SB(1, 0), cB + kstep, voffB); PG8_STAGE(PG8_SA(1, 0), cA + kstep, voffA); PG8_STAGE(PG8_SB(1, 1), cB + hB + kstep, voffB);
    PG8_WAIT_V(6); PG8_BAR;
    for (;;) {
        const bool has_next = S.next(ui + 1, nxt);
        const char* nA = has_next ? nxt.a : cA; const char* nB = has_next ? nxt.b : cB;
        for (int t = 0; t < nt; t += 2) {
            const bool last = (t == nt - 2);
            const char* a1 = cA + (size_t)(t + 1) * kstep;
            const char* a2 = last ? nA : cA + (size_t)(t + 2) * kstep; const char* b2 = last ? nB : cB + (size_t)(t + 2) * kstep;
            const char* a3 = a2 + kstep; const char* b3 = b2 + kstep;
            PG8_LDB(B0, 0, 0); PG8_LDB(B1, 0, 1); PG8_SCHED; PG8_LDA(At, 0, 0); PG8_STAGE(PG8_SA(1, 1), a1 + hA, voffA);
            PG8_WAIT_V(8); PG8_WAIT_L(0); PG8_BAR; PG8_MMA(0, 0, At, B0); PG8_MMA(0, 1, At, B1); PG8_BAR; PG8_SCHED;
            PG8_LDA(At, 0, 1); PG8_STAGE(PG8_SB(0, 0), b2, voffB); PG8_STAGE(PG8_SB(0, 1), b2 + hB, voffB); PG8_STAGE(PG8_SA(0, 0), a2, voffA);
            PG8_WAIT_V(8); PG8_WAIT_L(0); PG8_BAR; PG8_MMA(1, 0, At, B0); PG8_MMA(1, 1, At, B1); PG8_BAR; PG8_SCHED;
            PG8_LDB(B0, 1, 0); PG8_LDB(B1, 1, 1); PG8_SCHED; PG8_LDA(At, 1, 0); PG8_STAGE(PG8_SA(0, 1), a2 + hA, voffA);
            PG8_WAIT_V(8); PG8_WAIT_L(0); PG8_BAR; PG8_MMA(0, 0, At, B0); PG8_MMA(0, 1, At, B1); PG8_BAR; PG8_SCHED;
            PG8_LDA(At, 1, 1); PG8_STAGE(PG8_SB(1, 0), b3, voffB); PG8_STAGE(PG8_SB(1, 1), b3 + hB, voffB); PG8_STAGE(PG8_SA(1, 0), a3, voffA);
            PG8_WAIT_V(8); PG8_WAIT_L(0); PG8_BAR; PG8_MMA(1, 0, At, B0); PG8_MMA(1, 1, At, B1); PG8_BAR; PG8_SCHED;
        }
        if constexpr (ALIGN_EPI) { if (wr == 0) PG8_BAR; }
        E(acc, cur, wr, wc, fr, fq);
        if (!has_next) break;
#pragma unroll
        for (int a = 0; a < 2; ++a)
#pragma unroll
            for (int b = 0; b < 2; ++b)
#pragma unroll
                for (int m = 0; m < 4; ++m)
#pragma unroll
                    for (int n = 0; n < 2; ++n) acc[a][b][m][n] = (f32x4){0.f, 0.f, 0.f, 0.f};
        cur = nxt; cA = nA; cB = nB; ++ui;
        if constexpr (ALIGN_EPI) { if (wr == 1) PG8_BAR; }
    }
    PG8_WAIT_V(0);
    if constexpr (!ALIGN_EPI) { if (wr == 0) PG8_BAR; }
    PG8_BAR;
#undef PG8_SA
#undef PG8_SB
#undef PG8_STAGE
#undef PG8_LDA
#undef PG8_LDB
#undef PG8_MMA
#undef PG8_WAIT_V
#undef PG8_WAIT_L
#undef PG8_BAR
#undef PG8_SCHED
}
}

struct Args {
    const float* in[27]; float* out; unsigned char* ws;
};
enum { I_X = 0, I_MEM, I_F1PRE, I_F1WGU, I_F1WD, I_F1POST, I_MIXPRE, I_WIN, I_CONVW, I_CONVB, I_DTB, I_ALOG, I_DSKIP, I_SSDG, I_ATTG, I_WOUT, I_MIXPOST,
       I_XAPRE, I_MEMG, I_XAWQ, I_XAWKV, I_XAWO, I_XAPOST, I_F2PRE, I_F2WGU, I_F2WD, I_F2POST };

__device__ __forceinline__ int opaque_tid() { int t = threadIdx.x; asm volatile("" : "+v"(t)); return t; }
__device__ __forceinline__ int dest_row(int mode, int n0) {
    if (mode == 0) return n0;
    if (mode == 1) { const int bj = n0 / DFF, f = n0 % DFF; return 256 * (f / 128) + 128 * bj + (f % 128); }
    if (n0 < 1024) return n0; if (n0 < 2048) return n0 + 1024; if (n0 < 3072) return n0 + 1024; if (n0 < 4096) return n0 - 2048; return n0;
}
__device__ __forceinline__ void transpose_item(const float* W, int K, int Npitch, int nblk, bf16_t* WT, int mode, LAS float* scr, int item, int lane, const float* gk = nullptr) {
    const int kb = item / nblk, nb = item % nblk, k0 = 64 * kb, n0 = 32 * nb;
    float wv[32];
#pragma unroll
    for (int i = 0; i < 32; ++i) { const int kk = 2 * i + (lane >> 5); wv[i] = __builtin_nontemporal_load(W + (size_t)(k0 + kk) * Npitch + n0 + (lane & 31)); }
#pragma unroll
    for (int i = 0; i < 32; ++i) { const int kk = 2 * i + (lane >> 5); scr[kk * 33 + (lane & 31)] = gk ? wv[i] * gk[k0 + kk] : wv[i]; }
    asm volatile("s_waitcnt lgkmcnt(0)" ::: "memory");
    const int c = lane & 7; const int dr = dest_row(mode, n0);
#pragma unroll
    for (int j = 0; j < 4; ++j) { const int n = (lane >> 3) + 8 * j; const LAS float* s = scr + (8 * c) * 33 + n;
        u32x4 o; o.x = pk2(s[0 * 33], s[1 * 33]); o.y = pk2(s[2 * 33], s[3 * 33]); o.z = pk2(s[4 * 33], s[5 * 33]); o.w = pk2(s[6 * 33], s[7 * 33]);
        *(u32x4*)(WT + (size_t)(dr + n) * K + k0 + 8 * c) = o; }
    asm volatile("s_waitcnt lgkmcnt(0)" ::: "memory");
}
__device__ __forceinline__ void rms_rows_phase(const float* X, const float* g, bf16_t* O, int nrows, int gw, int NGW, int lane, float* RSout = nullptr) {
    f32x4 gg[4];
#pragma unroll
    for (int j = 0; j < 4; ++j) gg[j] = RSout ? (f32x4){1.f, 1.f, 1.f, 1.f} : ((const f32x4*)g)[lane + 64 * j];
    f32x4 a[4], n[4]; int m = gw;
    if (m < nrows) {
#pragma unroll
        for (int j = 0; j < 4; ++j) a[j] = __builtin_nontemporal_load((const f32x4*)(X + (size_t)m * DM) + lane + 64 * j); }
    for (; m < nrows; m += NGW) {
        const int mn = m + NGW;
        if (mn < nrows) {
#pragma unroll
            for (int j = 0; j < 4; ++j) n[j] = __builtin_nontemporal_load((const f32x4*)(X + (size_t)mn * DM) + lane + 64 * j); }
        float s = 0.f;
#pragma unroll
        for (int j = 0; j < 4; ++j) s += (a[j].x * a[j].x + a[j].y * a[j].y) + (a[j].z * a[j].z + a[j].w * a[j].w);
        float rs = rsqrtf(wave_sum(s) * (1.f / DM) + EPS);
        if (RSout) { if (lane == 0) RSout[m] = rs; rs = 1.f; }
        u32x2* o8 = (u32x2*)(O + (size_t)m * DM) + lane;
#pragma unroll
        for (int j = 0; j < 4; ++j) { u32x2 w; w.x = pk2(a[j].x * rs * gg[j].x, a[j].y * rs * gg[j].y); w.y = pk2(a[j].z * rs * gg[j].z, a[j].w * rs * gg[j].w); o8[64 * j] = w; }
#pragma unroll
        for (int j = 0; j < 4; ++j) a[j] = n[j];
    }
}
template <bool HIN_BF16, bool HOUT_BF16>
__device__ __forceinline__ void res_rows_phase(const bf16_t* F, const void* hin_, const float* gpost, float scale, void* hout_, float* RSout, int gw, int NGW, int lane) {
    f32x4 gp[4];
#pragma unroll
    for (int j = 0; j < 4; ++j) gp[j] = ((const f32x4*)gpost)[lane + 64 * j];
    u32x2 fa[4], fn[4]; f32x4 ha[4], hn[4]; int m = gw;
#define RR_LOADH(dst, row) do { if (HIN_BF16) { _Pragma("unroll") for (int j = 0; j < 4; ++j) { const u32x2 w_ = ((const u32x2*)((const bf16_t*)hin_ + (size_t)(row) * DM))[lane + 64 * j]; dst[j] = (f32x4){bflo(w_.x), bfhi(w_.x), bflo(w_.y), bfhi(w_.y)}; } } \
        else { _Pragma("unroll") for (int j = 0; j < 4; ++j) dst[j] = ((const f32x4*)((const float*)hin_ + (size_t)(row) * DM))[lane + 64 * j]; } } while (0)
    if (m < MTOK) {
#pragma unroll
        for (int j = 0; j < 4; ++j) fa[j] = ((const u32x2*)(F + (size_t)m * DM))[lane + 64 * j];
        RR_LOADH(ha, m); }
    for (; m < MTOK; m += NGW) {
        const int mn = m + NGW;
        if (mn < MTOK) {
#pragma unroll
            for (int j = 0; j < 4; ++j) fn[j] = ((const u32x2*)(F + (size_t)mn * DM))[lane + 64 * j];
            RR_LOADH(hn, mn); }
        f32x4 f[4]; float s = 0.f;
#pragma unroll
        for (int j = 0; j < 4; ++j) { f[j] = (f32x4){bflo(fa[j].x), bfhi(fa[j].x), bflo(fa[j].y), bfhi(fa[j].y)}; s += (f[j].x * f[j].x + f[j].y * f[j].y) + (f[j].z * f[j].z + f[j].w * f[j].w); }
        const float rs = rsqrtf(wave_sum(s) * (1.f / DM) + EPS) * scale; float s2 = 0.f;
#pragma unroll
        for (int j = 0; j < 4; ++j) { f[j] = ha[j] + f[j] * rs * gp[j];
            if (HOUT_BF16) { u32x2 w; w.x = pk2(f[j].x, f[j].y); w.y = pk2(f[j].z, f[j].w); ((u32x2*)((bf16_t*)hout_ + (size_t)m * DM))[lane + 64 * j] = w; }
            else ((f32x4*)((float*)hout_ + (size_t)m * DM))[lane + 64 * j] = f[j];
            s2 += (f[j].x * f[j].x + f[j].y * f[j].y) + (f[j].z * f[j].z + f[j].w * f[j].w); }
        if (RSout) { const float rs2 = rsqrtf(wave_sum(s2) * (1.f / DM) + EPS); if (lane == 0) RSout[m] = rs2; }
#pragma unroll
        for (int j = 0; j < 4; ++j) { fa[j] = fn[j]; ha[j] = hn[j]; }
    }
#undef RR_LOADH
}
__device__ __forceinline__ void mixnorm_phase(bf16_t* PROJ, const float* attg, const float* ssdg, int gw, int NGW, int lane) {
    f32x4 g0[4], g1[4];
#pragma unroll
    for (int j = 0; j < 4; ++j) { const float* g = (j < 2 ? attg + 512 * j : ssdg + 512 * (j - 2)) + 8 * lane; g0[j] = *(const f32x4*)g; g1[j] = *(const f32x4*)(g + 4); }
    u32x4 a[4], n[4]; int m = gw;
    if (m < MTOK) {
#pragma unroll
        for (int j = 0; j < 4; ++j) a[j] = ((const u32x4*)(PROJ + (size_t)m * LDP))[lane + 64 * j]; }
    for (; m < MTOK; m += NGW) {
        const int mn = m + NGW;
        if (mn < MTOK) {
#pragma unroll
            for (int j = 0; j < 4; ++j) n[j] = ((const u32x4*)(PROJ + (size_t)mn * LDP))[lane + 64 * j]; }
        float v[4][8]; float ss[4];
#pragma unroll
        for (int j = 0; j < 4; ++j) { const u32x4 w = a[j]; v[j][0] = bflo(w.x); v[j][1] = bfhi(w.x); v[j][2] = bflo(w.y); v[j][3] = bfhi(w.y); v[j][4] = bflo(w.z); v[j][5] = bfhi(w.z); v[j][6] = bflo(w.w); v[j][7] = bfhi(w.w);
            float s = 0.f;
#pragma unroll
            for (int i = 0; i < 8; ++i) s += v[j][i] * v[j][i];
            ss[j] = wave_sum(s); }
        const float rsa = rsqrtf((ss[0] + ss[1]) * (1.f / 1024.f) + EPS), rs0 = rsqrtf(ss[2] * (1.f / 512.f) + EPS), rs1 = rsqrtf(ss[3] * (1.f / 512.f) + EPS);
        u32x4* p = (u32x4*)(PROJ + (size_t)m * LDP) + lane;
#pragma unroll
        for (int j = 0; j < 4; ++j) { const float rs = j < 2 ? rsa : (j == 2 ? rs0 : rs1);
            u32x4 w; w.x = pk2(v[j][0] * rs * g0[j].x, v[j][1] * rs * g0[j].y); w.y = pk2(v[j][2] * rs * g0[j].z, v[j][3] * rs * g0[j].w); w.z = pk2(v[j][4] * rs * g1[j].x, v[j][5] * rs * g1[j].y); w.w = pk2(v[j][6] * rs * g1[j].z, v[j][7] * rs * g1[j].w);
            p[64 * j] = w; }
#pragma unroll
        for (int j = 0; j < 4; ++j) a[j] = n[j];
    }
}

constexpr int AT_STR = 72;
constexpr float SB_THR = 20.f;
__device__ __forceinline__ void attn_phase(bf16_t* PROJ, bf16_t* Odst, int opitch, int ocol, LAS unsigned char* lds, int bid, int G) {
    int tid = threadIdx.x; asm volatile("" : "+v"(tid)); const int lane = tid & 63; const int wid = __builtin_amdgcn_readfirstlane(tid >> 6);
    const int r32 = lane & 31, hi = lane >> 5;
    LAS bf16_t* VTs = (LAS bf16_t*)(lds + wid * (64 * AT_STR * 2));
    LAS bf16_t* Kt = (LAS bf16_t*)(lds + 8 * (64 * AT_STR * 2) + wid * 8192);
    const int vc = lane & 7, vp = lane >> 3;
    bf16x8 qn[4], kf[8]; u32x4 vr[8];
#define AT_DECODE(u_, b_, h_, qbase_) do { const int qb_ = 15 - ((u_) & 15), bh_ = (u_) >> 4; b_ = bh_ >> 4; h_ = bh_ & 15; qbase_ = qb_ * 256 + 32 * wid; } while (0)
#define AT_LOAD(b_, h_, t) do { int vp_ = vp, vc_ = vc; asm volatile("" : "+v"(vp_), "+v"(vc_));        \
        const bf16_t* Kl_ = PROJ + ((size_t)(b_) * SEQ + vp_) * LDP + PK + (h_) * 64 + 8 * vc_; const bf16_t* Vl_ = PROJ + ((size_t)(b_) * SEQ + 2 * vp_) * LDP + PV + (h_) * 64 + 8 * vc_; \
        _Pragma("unroll") for (int i_ = 0; i_ < 8; ++i_) kf[i_] = *(const bf16x8*)(Kl_ + (size_t)(64 * (t) + 8 * i_) * LDP); \
        _Pragma("unroll") for (int j_ = 0; j_ < 4; ++j_) { vr[2 * j_] = *(const u32x4*)(Vl_ + (size_t)(64 * (t) + 16 * j_) * LDP); vr[2 * j_ + 1] = *(const u32x4*)(Vl_ + (size_t)(64 * (t) + 16 * j_ + 1) * LDP); } } while (0)
#define AT_LOADQ(b_, h_, qbase_) do { const bf16_t* Qp_ = PROJ + ((size_t)(b_) * SEQ + (qbase_) + r32) * LDP + PQ + (h_) * 64 + 8 * hi; _Pragma("unroll") for (int d_ = 0; d_ < 4; ++d_) qn[d_] = *(const bf16x8*)(Qp_ + 16 * d_); } while (0)
    int u = bid;
    if (u >= 2048) return;
    int b, h, qbase; AT_DECODE(u, b, h, qbase);
    AT_LOADQ(b, h, qbase); AT_LOAD(b, h, (qbase + 30) >> 6);
    for (; u < 2048; u += G) {
        AT_DECODE(u, b, h, qbase);
        const int un = u + G; int bn = 0, hn = 0, qbn = 0; if (un < 2048) AT_DECODE(un, bn, hn, qbn);
        const int myq = qbase + r32; const int wqmax = qbase + 31;
        bf16x8 qr[4];
#pragma unroll
        for (int d0 = 0; d0 < 4; ++d0) qr[d0] = qn[d0];
        f32x16 o0, o1;
#pragma unroll
        for (int r = 0; r < 16; ++r) { o0[r] = 0.f; o1[r] = 0.f; }
        float R = 0.f;
        int jt = (qbase + 30) >> 6;
        for (;;) {
            int vck = vc, vpk = vp, r32k = r32; asm volatile("" : "+v"(vck), "+v"(vpk), "+v"(r32k));
#pragma unroll
            for (int i = 0; i < 8; ++i) *(LAS bf16x8*)(Kt + (8 * i + vpk) * 64 + 8 * (vck ^ ((4 * (i & 1) + (vpk >> 1)) & 7))) = kf[i];
            { LAS unsigned* vt32 = (LAS unsigned*)VTs;
#pragma unroll
              for (int j = 0; j < 4; ++j) { const u32x4 A = vr[2 * j], B = vr[2 * j + 1]; LAS unsigned* d = vt32 + ((8 * vc) * AT_STR + 2 * ((vp + 8 * j) ^ (4 * vc))) / 2;
                  d[0 * (AT_STR / 2)] = (A.x & 0xffffu) | (B.x << 16); d[1 * (AT_STR / 2)] = (A.x >> 16) | (B.x & 0xffff0000u);
                  d[2 * (AT_STR / 2)] = (A.y & 0xffffu) | (B.y << 16); d[3 * (AT_STR / 2)] = (A.y >> 16) | (B.y & 0xffff0000u);
                  d[4 * (AT_STR / 2)] = (A.z & 0xffffu) | (B.z << 16); d[5 * (AT_STR / 2)] = (A.z >> 16) | (B.z & 0xffff0000u);
                  d[6 * (AT_STR / 2)] = (A.w & 0xffffu) | (B.w << 16); d[7 * (AT_STR / 2)] = (A.w >> 16) | (B.w & 0xffff0000u); } }
            const bool pred_last = (jt == 0) || (64 * jt + 64 <= qbase);
            if (pred_last) { if (un < 2048) { AT_LOADQ(bn, hn, qbn); AT_LOAD(bn, hn, (qbn + 30) >> 6); } }
            else AT_LOAD(b, h, jt - 1);
#pragma unroll
            for (int sub = 1; sub >= 0; --sub) {
                const int kbase = 64 * jt + 32 * sub;
                if (kbase < wqmax && !(sub == 0 && __all(R >= SB_THR * 1.4426950408889634f))) {
                    f32x16 s;
#pragma unroll
                    for (int r = 0; r < 16; ++r) s[r] = 0.f;
#pragma unroll
                    for (int d0 = 0; d0 < 4; ++d0) { const bf16x8 kfr = *(const LAS bf16x8*)(Kt + (32 * sub + r32k) * 64 + 8 * ((2 * d0 + hi) ^ ((r32k >> 1) & 7)));
                        s = __builtin_amdgcn_mfma_f32_32x32x16_bf16(kfr, qr[d0], s, 0, 0, 0); }
                    float sp[16], T[4], U[4];
                    if (kbase + 31 >= qbase) {
#pragma unroll
                        for (int r = 0; r < 16; ++r) { const int key = kbase + crow(r, hi); const float zl = s[r] * (0.125f * 1.4426950408889634f);
                            const float v = fmaxf(zl, 0.f) + __builtin_amdgcn_logf(1.f + __builtin_amdgcn_exp2f(-fabsf(zl)));
                            const bool ok = key < myq; s[r] = ok ? zl : -1.0e30f; sp[r] = ok ? v : 0.f; }
                    } else {
#pragma unroll
                        for (int r = 0; r < 16; ++r) { const float zl = s[r] * (0.125f * 1.4426950408889634f); s[r] = zl;
                            sp[r] = fmaxf(zl, 0.f) + __builtin_amdgcn_logf(1.f + __builtin_amdgcn_exp2f(-fabsf(zl))); }
                    }
#pragma unroll
                    for (int g = 0; g < 4; ++g) { T[g] = (sp[4 * g] + sp[4 * g + 1]) + (sp[4 * g + 2] + sp[4 * g + 3]); U[g] = __shfl_xor(T[g], 32); }
                    float tail = 0.f; float a[16];
#pragma unroll
                    for (int g = 3; g >= 0; --g) { float run = R + tail + (hi == 0 ? U[g] : 0.f);
#pragma unroll
                        for (int e = 3; e >= 0; --e) { const int r = 4 * g + e; run += sp[r]; a[r] = __builtin_amdgcn_exp2f(s[r] - run); }
                        tail += T[g] + U[g]; }
                    R += tail;
                    bf16x8 pf[2];
#pragma unroll
                    for (int s2 = 0; s2 < 2; ++s2) { u32x4 w; w.x = pk2(a[8 * s2], a[8 * s2 + 1]); w.y = pk2(a[8 * s2 + 2], a[8 * s2 + 3]); w.z = pk2(a[8 * s2 + 4], a[8 * s2 + 5]); w.w = pk2(a[8 * s2 + 6], a[8 * s2 + 7]); pf[s2] = __builtin_bit_cast(bf16x8, w); }
#pragma unroll
                    for (int s2 = 0; s2 < 2; ++s2)
#pragma unroll
                        for (int dd = 0; dd < 2; ++dd) { const LAS bf16_t* vrow = VTs + r32k * AT_STR + 4 * hi + dd * 32 * AT_STR + 32 * (sub ^ dd);
                            const bf16x4 lo = *(const LAS bf16x4*)(vrow + ((8 * (r32k >> 3)) ^ (16 * s2))), hi4 = *(const LAS bf16x4*)(vrow + ((8 * (r32k >> 3)) ^ (16 * s2 + 8)));
                            const bf16x8 vf = (bf16x8){lo[0], lo[1], lo[2], lo[3], hi4[0], hi4[1], hi4[2], hi4[3]};
                            if (dd == 0) o0 = __builtin_amdgcn_mfma_f32_32x32x16_bf16(pf[s2], vf, o0, 0, 0, 0); else o1 = __builtin_amdgcn_mfma_f32_32x32x16_bf16(pf[s2], vf, o1, 0, 0, 0); }
                }
            }
            const bool done = (jt == 0) || (__all(R >= SB_THR * 1.4426950408889634f) != 0);
            if (done) { if (!pred_last && un < 2048) { AT_LOADQ(bn, hn, qbn); AT_LOAD(bn, hn, (qbn + 30) >> 6); } break; }
            if (pred_last) AT_LOAD(b, h, jt - 1);
            --jt;
        }
        { bf16_t* Op = Odst + ((size_t)b * SEQ + qbase) * opitch + ocol + h * 64 + r32;
#pragma unroll
          for (int r = 0; r < 16; ++r) { bf16_t* p = Op + (size_t)crow(r, hi) * opitch; p[0] = (bf16_t)f2bf(o0[r]); p[32] = (bf16_t)f2bf(o1[r]); } }
    }
#undef AT_LOAD
#undef AT_LOADQ
#undef AT_DECODE
}

constexpr int SS = 136;
constexpr int L_CS = 0, L_BS = 128 * SS * 2, L_BDT = 2 * 128 * SS * 2, L_XT = 3 * 128 * SS * 2, L_DT = L_XT + 64 * SS * 2, L_ACS = L_DT + 512, L_SSD_END = L_ACS + 512;
static_assert(L_SSD_END <= 131072, "ssd lds");
__device__ __forceinline__ void conv8(const bf16_t* PROJ, size_t T, int tl, int ch, const float* convw, const float* convb, float (&o)[8]) {
    { const f32x4 b0 = *(const f32x4*)(convb + ch), b1 = *(const f32x4*)(convb + ch + 4); o[0] = b0.x; o[1] = b0.y; o[2] = b0.z; o[3] = b0.w; o[4] = b1.x; o[5] = b1.y; o[6] = b1.z; o[7] = b1.w; }
    u32x4 w[4];
#pragma unroll
    for (int k = 0; k < 4; ++k) { const int tk = tl - 3 + k; const int tc = tk < 0 ? 0 : tk;
        w[k] = *(const u32x4*)(PROJ + (T - tl + tc) * LDP + PX + ch); const unsigned mk = tk < 0 ? 0u : 0xffffffffu; w[k].x &= mk; w[k].y &= mk; w[k].z &= mk; w[k].w &= mk; }
#pragma unroll
    for (int k = 0; k < 4; ++k) { const f32x4 w0 = *(const f32x4*)(convw + k * 1536 + ch), w1 = *(const f32x4*)(convw + k * 1536 + ch + 4);
        o[0] += bflo(w[k].x) * w0.x; o[1] += bfhi(w[k].x) * w0.y; o[2] += bflo(w[k].y) * w0.z; o[3] += bfhi(w[k].y) * w0.w;
        o[4] += bflo(w[k].z) * w1.x; o[5] += bfhi(w[k].z) * w1.y; o[6] += bflo(w[k].w) * w1.z; o[7] += bfhi(w[k].w) * w1.w; }
#pragma unroll
    for (int i = 0; i < 8; ++i) o[i] = silu_f(o[i]);
}
__device__ __forceinline__ void dt_acs(const float* DT, size_t T0, int h, float dbias, float Aneg, int lane, LAS float* dtL, LAS float* acsL) {
    const float d0 = softplus_f(DT[(T0 + lane) * 16 + h] + dbias), d1 = softplus_f(DT[(T0 + 64 + lane) * 16 + h] + dbias);
    float s0 = d0 * Aneg, s1 = d1 * Aneg;
#pragma unroll
    for (int o = 1; o < 64; o <<= 1) { const float t0 = __shfl_up(s0, o), t1 = __shfl_up(s1, o); if (lane >= o) { s0 += t0; s1 += t1; } }
    const float tot0 = __shfl(s0, 63); s1 += tot0;
    dtL[lane] = d0; dtL[64 + lane] = d1; acsL[lane] = s0; acsL[64 + lane] = s1;
}
__device__ __forceinline__ bf16_t* state_ptr(bf16_t* ST, size_t T0, int h, int n, int p) { return ST + ((T0 >> 7) * 16 + h) * 8192 + n * 64 + p; }

#define LDS_BAR() do { asm volatile("s_waitcnt lgkmcnt(0)" ::: "memory"); __builtin_amdgcn_s_barrier(); asm volatile("" ::: "memory"); } while (0)
struct ConvW { f32x4 cw[8]; f32x4 b0, b1; };
__device__ __forceinline__ void convw_load(ConvW& W, int ch, const float* convw, const float* convb) {
    W.b0 = *(const f32x4*)(convb + ch); W.b1 = *(const f32x4*)(convb + ch + 4);
#pragma unroll
    for (int k = 0; k < 4; ++k) { W.cw[2 * k] = *(const f32x4*)(convw + k * 1536 + ch); W.cw[2 * k + 1] = *(const f32x4*)(convw + k * 1536 + ch + 4); }
}
__device__ __forceinline__ void conv_raw_load(u32x4 (&w)[4], const bf16_t* PROJ, size_t T, int tl, int ch) {
#pragma unroll
    for (int k = 0; k < 4; ++k) { const int tk = tl - 3 + k; const int tc = tk < 0 ? 0 : tk;
        w[k] = *(const u32x4*)(PROJ + (T - tl + tc) * LDP + PX + ch); const unsigned mk = tk < 0 ? 0u : 0xffffffffu; w[k].x &= mk; w[k].y &= mk; w[k].z &= mk; w[k].w &= mk; }
}
__device__ __forceinline__ void conv_compute(const u32x4 (&w)[4], const ConvW& W, float (&o)[8]) {
    o[0] = W.b0.x; o[1] = W.b0.y; o[2] = W.b0.z; o[3] = W.b0.w; o[4] = W.b1.x; o[5] = W.b1.y; o[6] = W.b1.z; o[7] = W.b1.w;
#pragma unroll
    for (int k = 0; k < 4; ++k) { const f32x4 w0 = W.cw[2 * k], w1 = W.cw[2 * k + 1];
        o[0] += bflo(w[k].x) * w0.x; o[1] += bfhi(w[k].x) * w0.y; o[2] += bflo(w[k].y) * w0.z; o[3] += bfhi(w[k].y) * w0.w;
        o[4] += bflo(w[k].z) * w1.x; o[5] += bfhi(w[k].z) * w1.y; o[6] += bflo(w[k].w) * w1.z; o[7] += bfhi(w[k].w) * w1.w; }
#pragma unroll
    for (int i = 0; i < 8; ++i) o[i] = silu_f(o[i]);
}
constexpr int LA_DT = L_XT + 64 * SS * 2, LA_ACS = LA_DT + 4096, LA_END = LA_ACS + 4096;
static_assert(LA_END <= 131072, "ssd A lds");
__device__ __forceinline__ void ssdA_unit(int u, bf16_t* PROJ, bf16_t* ST, bf16_t* YP, float* CD, const float* DT, const float* convw, const float* convb, const float* dtb, const float* alog, const float* dskip, LAS unsigned char* lds) {
    int tid = threadIdx.x; asm volatile("" : "+v"(tid)); const int lane = tid & 63, r32 = lane & 31, hi = lane >> 5; const int wid = __builtin_amdgcn_readfirstlane(tid >> 6);
    const int b = u >> 6, c = (u >> 1) & 31, g = u & 1;
    LAS bf16_t* Cs = (LAS bf16_t*)(lds + L_CS); LAS bf16_t* Bs = (LAS bf16_t*)(lds + L_BS); LAS bf16_t* BdT = (LAS bf16_t*)(lds + L_BDT);
    LAS bf16_t* XT = (LAS bf16_t*)(lds + L_XT); LAS float* dtL8 = (LAS float*)(lds + LA_DT); LAS float* acsL8 = (LAS float*)(lds + LA_ACS); LAS bf16_t* Mm = Cs;
    const size_t T0 = (size_t)b * SEQ + (size_t)c * 128;
    const int nb = wid >> 1, pb = wid & 1;
    const int xl = tid >> 3, xv = tid & 7;
    { const int h = 8 * g + wid; dt_acs(DT, T0, h, dtb[h], -__expf(alog[h]), lane, dtL8 + wid * 128, acsL8 + wid * 128); }
    { ConvW W; const int v = tid & 31; const int ch = (v < 16) ? 1024 + g * 128 + v * 8 : 1280 + g * 128 + (v - 16) * 8; convw_load(W, ch, convw, convb);
      LAS bf16_t* dst0 = (v < 16) ? (Bs + v * 8) : (Cs + (v - 16) * 8);
#pragma unroll
      for (int jj = 0; jj < 2; ++jj) { u32x4 raw[4][4];
#pragma unroll
          for (int j = 0; j < 4; ++j) { const int l = (tid >> 5) + 16 * (4 * jj + j); conv_raw_load(raw[j], PROJ, T0 + l, c * 128 + l, ch); }
#pragma unroll
          for (int j = 0; j < 4; ++j) { const int l = (tid >> 5) + 16 * (4 * jj + j); float o[8]; conv_compute(raw[j], W, o);
              u32x4 w; w.x = pk2(o[0], o[1]); w.y = pk2(o[2], o[3]); w.z = pk2(o[4], o[5]); w.w = pk2(o[6], o[7]); *(LAS u32x4*)(dst0 + l * SS) = w; } } }
    u32x4 raw0[4], raw1[4]; ConvW XW;
    conv_raw_load(raw0, PROJ, T0 + xl, c * 128 + xl, 8 * g * 64 + xv * 8); conv_raw_load(raw1, PROJ, T0 + xl + 64, c * 128 + xl + 64, 8 * g * 64 + xv * 8); convw_load(XW, 8 * g * 64 + xv * 8, convw, convb);
    LDS_BAR();
    f32x16 cb[2];
#pragma unroll
    for (int r = 0; r < 16; ++r) { cb[0][r] = 0.f; cb[1][r] = 0.f; }
#pragma unroll
    for (int t = 0; t < 2; ++t) { const int id = wid + 8 * t, lb = id >> 2, sb = id & 3;
        if (sb <= lb) {
#pragma unroll
            for (int ks = 0; ks < 8; ++ks) { const bf16x8 af = *(const LAS bf16x8*)(Cs + (32 * lb + r32) * SS + 16 * ks + 8 * hi), bf = *(const LAS bf16x8*)(Bs + (32 * sb + r32) * SS + 16 * ks + 8 * hi);
                cb[t] = __builtin_amdgcn_mfma_f32_32x32x16_bf16(af, bf, cb[t], 0, 0, 0); } } }
    LDS_BAR();
#pragma unroll 1
    for (int r8 = 0; r8 < 8; ++r8) {
        const int h = 8 * g + r8; const float dsk = dskip[h];
        int r32v = r32, hiv = hi; asm volatile("" : "+v"(r32v), "+v"(hiv));
        LAS float* dtL = dtL8 + r8 * 128; LAS float* acsL = acsL8 + r8 * 128;
        { float o[8]; conv_compute(raw0, XW, o); LAS bf16_t* xd = XT + (xv * 8) * SS + (xl ^ (8 * xv));
#pragma unroll
          for (int i = 0; i < 8; ++i) xd[i * SS] = (bf16_t)f2bf(o[i]);
          conv_compute(raw1, XW, o); xd += 64;
#pragma unroll
          for (int i = 0; i < 8; ++i) xd[i * SS] = (bf16_t)f2bf(o[i]); }
        LDS_BAR();
        if (r8 < 7) { const int ch = (h + 1) * 64 + xv * 8; conv_raw_load(raw0, PROJ, T0 + xl, c * 128 + xl, ch); conv_raw_load(raw1, PROJ, T0 + xl + 64, c * 128 + xl + 64, ch); convw_load(XW, ch, convw, convb); }
        { const float alast = acsL[127];
#pragma unroll 1
          for (int it = tid; it < 128 * 16; it += 512) { const int l = it >> 4, nv = it & 15; const float wl = dtL[l] * __expf(alast - acsL[l]);
              const u32x4 w = *(const LAS u32x4*)(Bs + l * SS + nv * 8); LAS bf16_t* d = BdT + (nv * 8) * SS + (l ^ (8 * nv));
              d[0 * SS] = (bf16_t)f2bf(bflo(w.x) * wl); d[1 * SS] = (bf16_t)f2bf(bfhi(w.x) * wl); d[2 * SS] = (bf16_t)f2bf(bflo(w.y) * wl); d[3 * SS] = (bf16_t)f2bf(bfhi(w.y) * wl);
              d[4 * SS] = (bf16_t)f2bf(bflo(w.z) * wl); d[5 * SS] = (bf16_t)f2bf(bfhi(w.z) * wl); d[6 * SS] = (bf16_t)f2bf(bflo(w.w) * wl); d[7 * SS] = (bf16_t)f2bf(bfhi(w.w) * wl); }
          if (tid == 0) CD[(b * 16 + h) * 32 + c] = __expf(alast); }
#pragma unroll
        for (int t = 0; t < 2; ++t) { const int id = wid + 8 * t, lb = id >> 2, sb = id & 3;
            if (sb <= lb) { const int sidx = 32 * sb + r32v; const float as = acsL[sidx], ds = dtL[sidx];
#pragma unroll
                for (int r = 0; r < 16; ++r) { const int l = 32 * lb + crow(r, hiv); const float e = __expf(fminf(acsL[l] - as, 0.f)) * ((sidx <= l) ? ds : 0.f); Mm[l * SS + sidx] = (bf16_t)f2bf(cb[t][r] * e); } } }
        LDS_BAR();
        { f32x16 st, yd;
#pragma unroll
          for (int r = 0; r < 16; ++r) { st[r] = 0.f; yd[r] = 0.f; }
#pragma unroll
          for (int ks = 0; ks < 8; ++ks) { const bf16x8 af = *(const LAS bf16x8*)(BdT + (32 * nb + r32v) * SS + ((16 * ks + 8 * hiv) ^ ((32 * nb + r32v) & 120))), bf = *(const LAS bf16x8*)(XT + (32 * pb + r32v) * SS + ((16 * ks + 8 * hiv) ^ ((32 * pb + r32v) & 56)));
              st = __builtin_amdgcn_mfma_f32_32x32x16_bf16(af, bf, st, 0, 0, 0); }
          const int lb = nb;
#pragma unroll
          for (int ks = 0; ks < 8; ++ks) { if (ks < 2 * (lb + 1)) { const bf16x8 af = *(const LAS bf16x8*)(Mm + (32 * lb + r32v) * SS + 16 * ks + 8 * hiv), bf = *(const LAS bf16x8*)(XT + (32 * pb + r32v) * SS + ((16 * ks + 8 * hiv) ^ ((32 * pb + r32v) & 56)));
              yd = __builtin_amdgcn_mfma_f32_32x32x16_bf16(af, bf, yd, 0, 0, 0); } }
          const int p = 32 * pb + r32v;
#pragma unroll
          for (int r = 0; r < 16; ++r) { const int l = 32 * lb + crow(r, hiv); const float xs = bf2f(XT[p * SS + (l ^ (p & 56))]);
              YP[((T0 >> 7) * 16 + h) * 8192 + l * 64 + p] = (bf16_t)f2bf(yd[r] + dsk * xs);
              *state_ptr(ST, T0, h, 32 * nb + crow(r, hiv), p) = (bf16_t)f2bf(st[r]); } }
        LDS_BAR();
    }
}
__device__ __forceinline__ void ssd_scan(bf16_t* ST, const float* CD, int gtid, int nthreads) {
    for (int item = gtid; item < NB * 16 * 128 * 8; item += nthreads) {
        const int p8 = item & 7, n = (item >> 3) & 127, bh = item >> 10, b = bh >> 4, h = bh & 15;
        const float* cd = CD + bh * 32; float stt[8];
#pragma unroll
        for (int i = 0; i < 8; ++i) stt[i] = 0.f;
#pragma unroll 1
        for (int c0 = 0; c0 < 32; c0 += 16) { u32x4 v[16]; u32x4* ptr[16];
#pragma unroll
            for (int j = 0; j < 16; ++j) { ptr[j] = (u32x4*)state_ptr(ST, (size_t)b * SEQ + (size_t)(c0 + j) * 128, h, n, 8 * p8); v[j] = *ptr[j]; }
#pragma unroll
            for (int j = 0; j < 16; ++j) { u32x4 o; o.x = pk2(stt[0], stt[1]); o.y = pk2(stt[2], stt[3]); o.z = pk2(stt[4], stt[5]); o.w = pk2(stt[6], stt[7]); *ptr[j] = o;
                const float d = cd[c0 + j];
                stt[0] = stt[0] * d + bflo(v[j].x); stt[1] = stt[1] * d + bfhi(v[j].x); stt[2] = stt[2] * d + bflo(v[j].y); stt[3] = stt[3] * d + bfhi(v[j].y);
                stt[4] = stt[4] * d + bflo(v[j].z); stt[5] = stt[5] * d + bfhi(v[j].z); stt[6] = stt[6] * d + bflo(v[j].w); stt[7] = stt[7] * d + bfhi(v[j].w); } }
    }
}
constexpr int L2_CS = 0, L2_HT = 128 * SS * 2, L2_DT = L2_HT + 64 * SS * 2, L2_ACS = L2_DT + 4096;
__device__ __forceinline__ void ssdC_unit(int u, bf16_t* PROJ, bf16_t* ST, bf16_t* Zdst, int zpitch, int zcol, const bf16_t* YP, const float* DT, const float* convw, const float* convb, const float* dtb, const float* alog, LAS unsigned char* lds) {
    int tid = threadIdx.x; asm volatile("" : "+v"(tid)); const int lane = tid & 63, r32 = lane & 31, hi = lane >> 5; const int wid = __builtin_amdgcn_readfirstlane(tid >> 6);
    const int b = u >> 6, c = (u >> 1) & 31, g = u & 1;
    LAS bf16_t* Cs = (LAS bf16_t*)(lds + L2_CS); LAS bf16_t* HT = (LAS bf16_t*)(lds + L2_HT); LAS float* dtL8 = (LAS float*)(lds + L2_DT); LAS float* acsL8 = (LAS float*)(lds + L2_ACS);
    const size_t T0 = (size_t)b * SEQ + (size_t)c * 128;
    const int lb = wid >> 1, pb = wid & 1;
    const int hn = tid >> 3, hp8 = tid & 7;
    u32x4 hv[2];
#pragma unroll
    for (int j = 0; j < 2; ++j) hv[j] = *(const u32x4*)state_ptr(ST, T0, 8 * g, hn + 64 * j, 8 * hp8);
    { const int h = 8 * g + wid; dt_acs(DT, T0, h, dtb[h], -__expf(alog[h]), lane, dtL8 + wid * 128, acsL8 + wid * 128); }
    { ConvW W; const int v = tid & 15; const int ch = 1280 + g * 128 + v * 8; convw_load(W, ch, convw, convb); u32x4 raw[4][4];
#pragma unroll
      for (int j = 0; j < 4; ++j) { const int l = (tid >> 4) + 32 * j; conv_raw_load(raw[j], PROJ, T0 + l, c * 128 + l, ch); }
#pragma unroll
      for (int j = 0; j < 4; ++j) { const int l = (tid >> 4) + 32 * j; float o[8]; conv_compute(raw[j], W, o);
          u32x4 w; w.x = pk2(o[0], o[1]); w.y = pk2(o[2], o[3]); w.z = pk2(o[4], o[5]); w.w = pk2(o[6], o[7]); *(LAS u32x4*)(Cs + l * SS + v * 8) = w; } }
#pragma unroll 1
    for (int r8 = 0; r8 < 8; ++r8) {
        const int h = 8 * g + r8;
        int r32v = r32, hiv = hi; asm volatile("" : "+v"(r32v), "+v"(hiv));
        LAS float* acsL = acsL8 + r8 * 128;
#pragma unroll
        for (int j = 0; j < 2; ++j) { LAS bf16_t* d = HT + (8 * hp8) * SS + ((hn + 64 * j) ^ (8 * hp8)); const u32x4 w = hv[j];
            d[0] = (bf16_t)(w.x & 0xffff); d[SS] = (bf16_t)(w.x >> 16); d[2 * SS] = (bf16_t)(w.y & 0xffff); d[3 * SS] = (bf16_t)(w.y >> 16); d[4 * SS] = (bf16_t)(w.z & 0xffff); d[5 * SS] = (bf16_t)(w.z >> 16); d[6 * SS] = (bf16_t)(w.w & 0xffff); d[7 * SS] = (bf16_t)(w.w >> 16); }
        LDS_BAR();
        if (r8 < 7) {
#pragma unroll
            for (int j = 0; j < 2; ++j) hv[j] = *(const u32x4*)state_ptr(ST, T0, h + 1, hn + 64 * j, 8 * hp8); }
        { const int p = 32 * pb + r32v; unsigned short ypv[16], zv[16];
#pragma unroll
          for (int r = 0; r < 16; ++r) { const int l = 32 * lb + crow(r, hiv); ypv[r] = YP[((T0 >> 7) * 16 + h) * 8192 + l * 64 + p]; zv[r] = PROJ[(T0 + l) * LDP + PZ + h * 64 + p]; }
          f32x16 yo;
#pragma unroll
          for (int r = 0; r < 16; ++r) yo[r] = 0.f;
#pragma unroll
          for (int ks = 0; ks < 8; ++ks) { const bf16x8 af = *(const LAS bf16x8*)(Cs + (32 * lb + r32v) * SS + 16 * ks + 8 * hiv), bf = *(const LAS bf16x8*)(HT + (32 * pb + r32v) * SS + ((16 * ks + 8 * hiv) ^ ((32 * pb + r32v) & 56)));
              yo = __builtin_amdgcn_mfma_f32_32x32x16_bf16(af, bf, yo, 0, 0, 0); }
#pragma unroll
          for (int r = 0; r < 16; ++r) { const int l = 32 * lb + crow(r, hiv);
              const float y = bf2f(ypv[r]) + __expf(acsL[l]) * yo[r]; const float z = bf2f(zv[r]);
              Zdst[(T0 + l) * zpitch + zcol + h * 64 + p] = (bf16_t)f2bf(y * silu_f(z)); } }
        LDS_BAR();
    }
}

#define XB_TMO      128
#define XB_XCNT(j)  (256  + 64 * (j))
#define XB_XSUB(j)  (1280 + 64 * (j))
#define XB_XGEN(j)  (2304 + 64 * (j))
#define XB_TOP      3328
#define XB_TOPGEN   3392
#define XCD_BAR_WORDS 3456
#define XB_SPIN_CAP (1u << 18)
__device__ __forceinline__ unsigned xb_ld(unsigned* p)              { return __hip_atomic_load(p, __ATOMIC_RELAXED, __HIP_MEMORY_SCOPE_AGENT); }
__device__ __forceinline__ unsigned xb_add(unsigned* p, unsigned v) { return __hip_atomic_fetch_add(p, v, __ATOMIC_RELAXED, __HIP_MEMORY_SCOPE_AGENT); }
__device__ __forceinline__ unsigned xb_xcc_id() { return (unsigned)__builtin_amdgcn_s_getreg((3 << 11) | 20) & 0xFu; }
#define XB_SPIN(cond, bar) do { unsigned _sp = 0; while (cond) { __builtin_amdgcn_s_sleep(1); \
    if ((++_sp & 255u) == 0u) { if (xb_ld(&(bar)[XB_TMO])) break; if (_sp > XB_SPIN_CAP) { atomicAdd(&(bar)[XB_TMO], 1u); break; } } } } while (0)
struct XcdBarrier { unsigned* bar; unsigned x; volatile LAS unsigned* st; };
__device__ __forceinline__ XcdBarrier xcd_barrier_post(unsigned* bar, volatile LAS unsigned* st) {
    XcdBarrier b; b.bar = bar; b.x = xb_xcc_id(); b.st = st;
    if (threadIdx.x == 0) (void)xb_add(&bar[XB_XCNT(b.x)], 1u);
    return b;
}
__device__ __forceinline__ void xcd_barrier_complete(unsigned* bar, unsigned x, unsigned& nloc, unsigned& nx) {
    const unsigned G = gridDim.x * gridDim.y * gridDim.z;
    unsigned sum, cnt, mine, sp = 0u;
    for (;;) {
        sum = 0u; cnt = 0u; mine = 0u;
#pragma unroll
        for (unsigned j = 0; j < 16; ++j) { const unsigned c = xb_ld(&bar[XB_XCNT(j)]); sum += c; cnt += (c > 0u) ? 1u : 0u; mine = (j == x) ? c : mine; }
        if (sum == G) break;
        __builtin_amdgcn_s_sleep(1);
        if ((++sp & 255u) == 0u) { if (xb_ld(&bar[XB_TMO])) break; if (sp > XB_SPIN_CAP) { atomicAdd(&bar[XB_TMO], 1u); break; } }
    }
    nloc = mine > 0u ? mine : 1u; nx = cnt > 0u ? cnt : 1u;
}
__device__ __forceinline__ void xcd_barrier(const XcdBarrier& b) {
    asm volatile("s_waitcnt vmcnt(0)" ::: "memory");
    __syncthreads();
    if (threadIdx.x == 0) {
        unsigned* bar = b.bar;
        __builtin_amdgcn_s_waitcnt(0);
        unsigned nloc = b.st[0], nx = b.st[1];
        if (nloc == 0u) { xcd_barrier_complete(bar, b.x, nloc, nx); b.st[0] = nloc; b.st[1] = nx; }
        const unsigned old = xb_add(&bar[XB_XSUB(b.x)], 1u);
        const unsigned gen = old / nloc;
        if (old + 1u == (gen + 1u) * nloc) {
            __builtin_amdgcn_fence(__ATOMIC_RELEASE, "agent");
            asm volatile("s_waitcnt vmcnt(0)" ::: "memory");
            const unsigned og = xb_add(&bar[XB_TOP], 1u);
            const unsigned tg = og / nx;
            if (og + 1u == (tg + 1u) * nx) xb_add(&bar[XB_TOPGEN], 1u);
            else XB_SPIN(xb_ld(&bar[XB_TOPGEN]) == tg, bar);
            __builtin_amdgcn_fence(__ATOMIC_ACQUIRE, "agent");
            xb_add(&bar[XB_XGEN(b.x)], 1u);
            asm volatile("s_waitcnt vmcnt(0)" ::: "memory");
        } else {
            XB_SPIN(xb_ld(&bar[XB_XGEN(b.x)]) == gen, bar);
            __builtin_amdgcn_fence(__ATOMIC_ACQUIRE, "agent");
            asm volatile("s_waitcnt vmcnt(0)" ::: "memory");
        }
    }
    __syncthreads();
}

constexpr int LDS_BYTES = 147456; constexpr int SPARE_OFF = 131072;
__global__ void __launch_bounds__(512, 2) mega_fwd(Args args) {
    extern __shared__ __attribute__((aligned(16))) unsigned char lds_raw[];
    LAS unsigned char* lds = (LAS unsigned char*)lds_raw;
    cg::grid_group grid = cg::this_grid();
    const int tid = threadIdx.x, lane = tid & 63; const int wave = __builtin_amdgcn_readfirstlane(tid >> 6);
    const int G = gridDim.x, bid = blockIdx.x; const int gw = bid * NWAVES + wave, NGW = G * NWAVES;
    unsigned char* ws = args.ws;
    bf16_t* WGU1 = (bf16_t*)(ws + WS_WGU1); bf16_t* WD1 = (bf16_t*)(ws + WS_WD1); bf16_t* WIN = (bf16_t*)(ws + WS_WIN); bf16_t* WOUT = (bf16_t*)(ws + WS_WOUT);
    bf16_t* WQ = (bf16_t*)(ws + WS_WQ); bf16_t* WKV = (bf16_t*)(ws + WS_WKV); bf16_t* WO = (bf16_t*)(ws + WS_WO); bf16_t* WGU2 = (bf16_t*)(ws + WS_WGU2); bf16_t* WD2 = (bf16_t*)(ws + WS_WD2);
    bf16_t* MEMN = (bf16_t*)(ws + WS_MEMN); bf16_t* K2 = (bf16_t*)(ws + WS_K2); bf16_t* VT = (bf16_t*)(ws + WS_VT); float* DT = (float*)(ws + WS_DT);
    bf16_t* XN = (bf16_t*)(ws + WS_XN); bf16_t* BIG = (bf16_t*)(ws + WS_BIG);
    bf16_t* PROJ = BIG; bf16_t* ACT = BIG; bf16_t* Q2 = BIG; bf16_t* PB = BIG + (size_t)MTOK * DM;
    unsigned* ctl = (unsigned*)(ws + WS_CTL);
    const float* x = args.in[I_X]; float* H = args.out;
    bf16_t* HB = (bf16_t*)args.out;
    bf16_t* HB3 = (bf16_t*)(ws + WS_BIG + 200 * MiB);
    float* RS0 = (float*)(ws + WS_CTL + 131072);
    float* RSP1 = (float*)(ws + 74 * MiB); float* RSP2 = RSP1 + (size_t)MTOK * 4; float* RSP3 = RSP2 + (size_t)MTOK * 4;
    float* XB = (float*)(ws + WS_CTL + 1 * MiB);
    unsigned* XCNT = (unsigned*)(ws + WS_CTL + 32768);
    LAS float* XL = (LAS float*)(lds + SPARE_OFF);
    if (tid < 16) ((LAS unsigned*)(lds + LDS_BYTES - 64))[tid] = 0u;
    __syncthreads();
    for (int i = bid * 512 + tid; i < 16384; i += G * 512) ctl[i] = 0u;
#define GRID_BAR() xcd_barrier(xbar)

    {
        LAS float* scr = (LAS float*)(lds + wave * 16384);
        constexpr int I_GU = 16 * 176, I_D = 44 * 32, I_INP = 16 * 176, I_OUT = 32 * 32, I_Q = 16 * 32, I_KV = 16 * 64;
        constexpr int NITEMS = 2 * I_GU + 2 * I_D + I_INP + I_OUT + I_Q + I_KV;
        for (int it = gw; it < NITEMS; it += NGW) {
            int r = it;
            if (r < I_GU) { transpose_item(args.in[I_F1WGU], 1024, NGU, 176, WGU1, 1, scr, r, lane, args.in[I_F1PRE]); continue; } r -= I_GU;
            if (r < I_GU) { transpose_item(args.in[I_F2WGU], 1024, NGU, 176, WGU2, 1, scr, r, lane, args.in[I_F2PRE]); continue; } r -= I_GU;
            if (r < I_D) { transpose_item(args.in[I_F1WD], DFF, 1024, 32, WD1, 0, scr, r, lane); continue; } r -= I_D;
            if (r < I_D) { transpose_item(args.in[I_F2WD], DFF, 1024, 32, WD2, 0, scr, r, lane); continue; } r -= I_D;
            if (r < I_INP) { transpose_item(args.in[I_WIN], 1024, DIN_SRC, 176, WIN, 2, scr, r, lane, args.in[I_MIXPRE]); continue; } r -= I_INP;
            if (r < I_OUT) { transpose_item(args.in[I_WOUT], 2048, 1024, 32, WOUT, 0, scr, r, lane); continue; } r -= I_OUT;
            if (r < I_Q) { transpose_item(args.in[I_XAWO], 1024, 1024, 32, WO, 0, scr, r, lane); continue; } r -= I_Q;
            transpose_item(args.in[I_XAWKV], 1024, 2048, 64, WKV, 0, scr, r, lane);
        }
        for (int i = bid * 512 + tid; i < 1024 * 1024 / 8; i += G * 512) { const f32x4 a = ((const f32x4*)args.in[I_XAWQ])[2 * i], b2 = ((const f32x4*)args.in[I_XAWQ])[2 * i + 1];
            const float gk = args.in[I_XAPRE][i >> 7];
            u32x4 w; w.x = pk2(a.x * gk, a.y * gk); w.y = pk2(a.z * gk, a.w * gk); w.z = pk2(b2.x * gk, b2.y * gk); w.w = pk2(b2.z * gk, b2.w * gk); ((u32x4*)WQ)[i] = w; }
        for (int i = bid * 512 + tid; i < 256 * 1024; i += G * 512) { const int rr = i >> 10, k = i & 1023; const float v = (rr < 16) ? args.in[I_WIN][(size_t)k * DIN_SRC + 5632 + rr] * args.in[I_MIXPRE][k] : 0.f; WIN[(size_t)(5632 + rr) * 1024 + k] = (bf16_t)f2bf(v); }
        rms_rows_phase(x, args.in[I_F1PRE], XN, MTOK, gw, NGW, lane, RS0);
        rms_rows_phase(args.in[I_MEM], args.in[I_MEMG], MEMN, 2048, gw, NGW, lane);
    }
    grid.sync();
    const XcdBarrier xbar = xcd_barrier_post(ctl + 4096, (volatile LAS unsigned*)(lds + LDS_BYTES - 32));
    { pg8::Sched S = pg8::make_sched(XN, 1024, WGU1, 1024, MTOK, NGU, 1024, G, bid); pg8::EpiSwiglu E{ACT, DFF, RS0, false}; pg8::gemm_phase<pg8::EpiSwiglu, true>(lds, S, E); }
    GRID_BAR();
    { pg8::Sched S = pg8::make_sched(ACT, DFF, WD1, DFF, MTOK, 1024, DFF, G, bid);
      pg8::EpiResX<false> E{XN, HB, args.in[I_F1POST], 0.5f, RSP1, XB, XCNT + 0 * 128 * 16, XL}; pg8::gemm_phase<pg8::EpiResX<false>, true>(lds, S, E); }
    GRID_BAR();
    { pg8::Sched S = pg8::make_sched(HB, 1024, WIN, 1024, MTOK, NIN, 1024, G, bid); pg8::EpiInProj E{PROJ, DT, RSP1, true}; pg8::gemm_phase<pg8::EpiInProj, true>(lds, S, E); }
    { const int c2 = (G >= 256) ? bid - 128 : bid;
      pg8::Sched S = pg8::make_sched(MEMN, 1024, WKV, 1024, 2048, 2048, 1024, (G >= 256) ? 64 : G, (G >= 256) ? ((c2 >= 0 && c2 < 64) ? c2 : -1) : bid); pg8::EpiStore E{K2, 2048}; pg8::gemm_phase<pg8::EpiStore, true>(lds, S, E); }
    GRID_BAR();
    bf16_t* WQK = (bf16_t*)(ws + WS_WQK);
    { pg8::Sched S = pg8::make_sched(K2, 2048, WQ, 1024, 256, 1024, 256, G, bid); S.nBt = 32; S.nH = 4;
      S.sAb = (long)256 * 2048 * 2; S.sAh = 256 * 2; S.sBb = 0; S.sBh = 256 * 2; S.sOb = (long)1024 * 1024; S.sOh = (long)256 * 1024;
      pg8::EpiStore E{WQK, 1024}; pg8::gemm_phase<pg8::EpiStore, true>(lds, S, E); }
    attn_phase(PROJ, PROJ, LDP, PQ, lds, bid, G);
    __syncthreads();
    float* CD = (float*)(ws + WS_CTL + 65536);
    bf16_t* ST = (bf16_t*)args.out + (size_t)MTOK * DM;
    for (int u = bid; u < 512; u += G) ssdA_unit(u, PROJ, ST, XN, CD, DT, args.in[I_CONVW], args.in[I_CONVB], args.in[I_DTB], args.in[I_ALOG], args.in[I_DSKIP], lds);
    GRID_BAR();
    ssd_scan(ST, CD, bid * 512 + opaque_tid(), G * 512);
    GRID_BAR();
    for (int u = bid; u < 512; u += G) ssdC_unit(u, PROJ, ST, PROJ, LDP, PZ, XN, DT, args.in[I_CONVW], args.in[I_CONVB], args.in[I_DTB], args.in[I_ALOG], lds);
    GRID_BAR();
    { const int ot = opaque_tid(); mixnorm_phase(PROJ, args.in[I_ATTG], args.in[I_SSDG], bid * NWAVES + __builtin_amdgcn_readfirstlane(ot >> 6), NGW, ot & 63); }
    GRID_BAR();
    { pg8::Sched S = pg8::make_sched(PROJ, LDP, WOUT, 2048, MTOK, 1024, 2048, G, bid);
      pg8::EpiResX<false> E{HB, HB, args.in[I_MIXPOST], 1.0f, RSP2, XB, XCNT + 1 * 128 * 16, XL}; pg8::gemm_phase<pg8::EpiResX<false>, true>(lds, S, E); }
    GRID_BAR();
    bf16_t* VW = BIG;
    { pg8::Sched S = pg8::make_sched(WO, 1024, K2 + 1024, 2048, 1024, 256, 256, G, bid); S.nBt = 32; S.nH = 4;
      S.sAb = 0; S.sAh = 256 * 2; S.sBb = (long)256 * 2048 * 2; S.sBh = 256 * 2; S.sOb = (long)1024 * 1024; S.sOh = 256;
      pg8::EpiStore E{VW, 1024}; pg8::gemm_phase<pg8::EpiStore, true>(lds, S, E); }
    { pg8::Sched S = pg8::make_sched(HB, 1024, WQK, 1024, SEQ, 1024, 1024, G, bid); S.nBt = 8; S.nH = 1; S.sRb = SEQ;
      S.sAb = (long)SEQ * 1024 * 2; S.sAh = 0; S.sBb = (long)1024 * 1024 * 2; S.sBh = 0; S.sOb = (long)SEQ * 1024; S.sOh = 0;
      pg8::EpiSoftmax E{PB, 1024, 0.0625f, (LAS float*)(lds + SPARE_OFF), RSP2}; pg8::gemm_phase<pg8::EpiSoftmax, true>(lds, S, E); }
    GRID_BAR();
    { pg8::Sched S = pg8::make_sched(PB, 1024, VW, 1024, SEQ, 1024, 1024, G, bid); S.nBt = 8; S.nH = 1; S.sRb = SEQ;
      S.sAb = (long)SEQ * 1024 * 2; S.sAh = 0; S.sBb = (long)1024 * 1024 * 2; S.sBh = 0; S.sOb = (long)SEQ * 1024; S.sOh = 0;
      pg8::EpiResX<false> E{HB, HB3, args.in[I_XAPOST], 1.0f, RSP3, XB, XCNT + 2 * 128 * 16, XL}; pg8::gemm_phase<pg8::EpiResX<false>, true>(lds, S, E); }
    GRID_BAR();
    { pg8::Sched S = pg8::make_sched(HB3, 1024, WGU2, 1024, MTOK, NGU, 1024, G, bid); pg8::EpiSwiglu E{ACT, DFF, RSP3, true}; pg8::gemm_phase<pg8::EpiSwiglu, true>(lds, S, E); }
    GRID_BAR();
    { pg8::Sched S = pg8::make_sched(ACT, DFF, WD2, DFF, MTOK, 1024, DFF, G, bid);
      pg8::EpiResX<true> E{HB3, H, args.in[I_F2POST], 0.5f, nullptr, XB, XCNT + 3 * 128 * 16, XL}; pg8::gemm_phase<pg8::EpiResX<true>, true>(lds, S, E); }
}

extern "C" void kernel_launch(void* const* d_in, const int* in_sizes, int n_in, void* d_out, int out_size, void* d_ws, size_t ws_size, hipStream_t stream) {
    static int grid = 0;
    if (grid == 0) {
        if (n_in != 27 || out_size != MTOK * DM || ws_size < WS_END) { fprintf(stderr, "kernel_launch: unexpected sizes n_in %d out %d ws %zu\n", n_in, out_size, ws_size); grid = -1; return; }
        int dev = 0, cus = 0, per_cu = 0;
        hipGetDevice(&dev); hipDeviceGetAttribute(&cus, hipDeviceAttributeMultiprocessorCount, dev);
        if (hipFuncSetAttribute((const void*)mega_fwd, hipFuncAttributeMaxDynamicSharedMemorySize, LDS_BYTES) != hipSuccess) { fprintf(stderr, "kernel_launch: hipFuncSetAttribute failed\n"); grid = -1; return; }
        if (hipOccupancyMaxActiveBlocksPerMultiprocessor(&per_cu, (const void*)mega_fwd, 512, LDS_BYTES) != hipSuccess || per_cu < 1) { fprintf(stderr, "kernel_launch: occupancy query says %d\n", per_cu); per_cu = 1; }
        (void)hipGetLastError();
        grid = cus;
        if (grid < 128) { fprintf(stderr, "kernel_launch: needs >= 128 CUs\n"); }
    }
    if (grid < 0) return;
    Args a{};
    for (int i = 0; i < 27; ++i) a.in[i] = (const float*)d_in[i];
    a.out = (float*)d_out; a.ws = (unsigned char*)d_ws;
    void* kargs[] = {&a};
    hipError_t e = hipLaunchCooperativeKernel((const void*)mega_fwd, dim3(grid), dim3(512), kargs, LDS_BYTES, stream);
    if (e != hipSuccess) fprintf(stderr, "cooperative launch failed: %s (grid %d)\n", hipGetErrorString(e), grid);
}
```
